# Optimizing an MI355X kernel written in HIP

```python
import jax, jax.numpy as jnp
from jax import lax
import numpy as np

D_MODEL = 2048
BATCH = 8
SEQ = 2048
DEPTH = 2

RET_HEADS = 4
RET_QK_DIM = 256
RET_V_DIM = 512
RET_CHUNK = 128
D_QK = RET_HEADS * RET_QK_DIM
D_RV = RET_HEADS * RET_V_DIM
ROPE_BASE = 10000.0
D_CONV = D_MODEL
CONV_K = 3
D_FF = 5632
N_EXPERTS = 8
TOP_K = 2
D_FF_EXPERT = 5632
EPS = 1e-6
N_DENSE = (DEPTH + 1) // 2
N_MOE = DEPTH // 2
IN_SIZES = [D_QK, D_QK, D_RV, D_RV, D_CONV, D_CONV, D_CONV, D_MODEL, D_MODEL]
D_IN_TOTAL = int(sum(IN_SIZES))
SPLIT_POINTS = [int(s) for s in np.cumsum(IN_SIZES)[:-1]]

kernel_name = "hybrid_retention_shortconv_gated_moe"


def rmsnorm(x, g):
    xf = x.astype(jnp.float32)
    y = xf * lax.rsqrt(jnp.mean(xf * xf, axis=-1, keepdims=True) + EPS)
    return (y * g.astype(jnp.float32)).astype(x.dtype)


def rotary(x, pos):
    half = x.shape[-1] // 2
    inv_freq = ROPE_BASE ** (-jnp.arange(half, dtype=jnp.float32) / half)
    ang = pos.astype(jnp.float32)[..., None] * inv_freq
    cos = jnp.cos(ang)[:, :, None, :]
    sin = jnp.sin(ang)[:, :, None, :]
    xf = x.astype(jnp.float32)
    x1, x2 = xf[..., :half], xf[..., half:]
    return jnp.concatenate([x1 * cos - x2 * sin, x1 * sin + x2 * cos], axis=-1)


def retention(q, k, v):
    bsz, t, h, dk = q.shape
    dv = v.shape[-1]
    n_chunks = t // RET_CHUNK
    log_gamma = jnp.log1p(-jnp.power(2.0, -5.0 - jnp.arange(h, dtype=jnp.float32)))
    idx = jnp.arange(RET_CHUNK, dtype=jnp.float32)
    diff = idx[:, None] - idx[None, :]
    causal = diff >= 0
    decay_mask = jnp.where(causal[None],
                           jnp.exp(jnp.where(causal, diff, 0.0)[None] * log_gamma[:, None, None]),
                           0.0)
    xi = jnp.exp((idx + 1.0)[None] * log_gamma[:, None])
    zeta = jnp.exp((RET_CHUNK - 1.0 - idx)[None] * log_gamma[:, None])
    gamma_chunk = jnp.exp(RET_CHUNK * log_gamma)

    def to_chunks(a):
        return a.reshape(bsz, n_chunks, RET_CHUNK, h, a.shape[-1]).transpose(1, 0, 3, 2, 4)

    def step(state, qkv):
        qc, kc, vc = qkv
        scores = jnp.einsum('bhqd,bhkd->bhqk', qc, kc) * decay_mask[None]
        inner = jnp.einsum('bhqk,bhkv->bhqv', scores, vc)
        cross = jnp.einsum('bhqd,bhdv->bhqv', qc, state) * xi[None, :, :, None]
        new_state = state * gamma_chunk[None, :, None, None] + jnp.einsum(
            'bhkd,bhkv->bhdv', kc * zeta[None, :, :, None], vc)
        return new_state, inner + cross

    state0 = jnp.zeros((bsz, h, dk, dv), jnp.float32)
    _, out = lax.scan(step, state0, (to_chunks(q), to_chunks(k), to_chunks(v)))
    return out.transpose(1, 0, 3, 2, 4).reshape(bsz, t, h, dv)


def head_groupnorm(o):
    mu = jnp.mean(o, axis=-1, keepdims=True)
    var = jnp.mean(jnp.square(o - mu), axis=-1, keepdims=True)
    return (o - mu) * lax.rsqrt(var + EPS)


def causal_depthwise_conv(u, w):
    c = u.shape[-1]
    return lax.conv_general_dilated(
        u, w[:, None, :].astype(u.dtype), window_strides=(1,),
        padding=[(CONV_K - 1, 0)], dimension_numbers=('NWC', 'WIO', 'NWC'),
        feature_group_count=c)


def swiglu(x, w1, w3, w2):
    return (jax.nn.silu(x @ w1) * (x @ w3)) @ w2


def moe_swiglu(x, router, w1, w3, w2):
    xt = x.reshape(-1, x.shape[-1])
    logits = (xt @ router).astype(jnp.float32)
    top_val, top_idx = lax.top_k(logits, TOP_K)
    gates = jax.nn.softmax(top_val, axis=-1)
    out = jnp.zeros(xt.shape, jnp.float32)
    for e in range(N_EXPERTS):
        w_e = jnp.sum(jnp.where(top_idx == e, gates, 0.0), axis=-1)
        out = out + w_e[:, None] * swiglu(xt, w1[e], w3[e], w2[e]).astype(jnp.float32)
    return out.astype(x.dtype).reshape(x.shape)


def setup_inputs(seed: int = 0) -> dict:
    key = jax.random.key(seed)
    ks = jax.random.split(key, 18)
    f32 = jnp.float32

    def nrm(k, shape, fan_in):
        return jax.random.normal(k, shape, f32) * (fan_in ** -0.5)

    x = jax.random.normal(ks[0], (BATCH, SEQ, D_MODEL), f32)
    offsets = jax.random.randint(ks[1], (BATCH, 1), 0, 1024, dtype=jnp.int32)
    positions = (offsets + jnp.arange(SEQ, dtype=jnp.int32)[None, :]).astype(jnp.int32)
    norm_mix = 1.0 + 0.02 * jax.random.normal(ks[2], (DEPTH, D_MODEL), f32)
    norm_ffn = 1.0 + 0.02 * jax.random.normal(ks[3], (DEPTH, D_MODEL), f32)
    norm_final = 1.0 + 0.02 * jax.random.normal(ks[4], (D_MODEL,), f32)
    w_in = nrm(ks[5], (DEPTH, D_MODEL, D_IN_TOTAL), D_MODEL)
    conv_w = nrm(ks[6], (DEPTH, CONV_K, D_CONV), CONV_K)
    w_ret_out = nrm(ks[7], (DEPTH, D_RV, D_MODEL), D_RV)
    w_conv_out = nrm(ks[8], (DEPTH, D_CONV, D_MODEL), D_CONV)
    w_out = nrm(ks[9], (DEPTH, D_MODEL, D_MODEL), D_MODEL)
    ffn_w1 = nrm(ks[10], (N_DENSE, D_MODEL, D_FF), D_MODEL)
    ffn_w3 = nrm(ks[11], (N_DENSE, D_MODEL, D_FF), D_MODEL)
    ffn_w2 = nrm(ks[12], (N_DENSE, D_FF, D_MODEL), D_FF)
    router = nrm(ks[13], (N_MOE, D_MODEL, N_EXPERTS), D_MODEL)
    moe_w1 = nrm(ks[14], (N_MOE, N_EXPERTS, D_MODEL, D_FF_EXPERT), D_MODEL)
    moe_w3 = nrm(ks[15], (N_MOE, N_EXPERTS, D_MODEL, D_FF_EXPERT), D_MODEL)
    moe_w2 = nrm(ks[16], (N_MOE, N_EXPERTS, D_FF_EXPERT, D_MODEL), D_FF_EXPERT)
    return {"x": x, "positions": positions, "norm_mix": norm_mix, "norm_ffn": norm_ffn,
            "norm_final": norm_final, "w_in": w_in, "conv_w": conv_w, "w_ret_out": w_ret_out,
            "w_conv_out": w_conv_out, "w_out": w_out, "ffn_w1": ffn_w1, "ffn_w3": ffn_w3,
            "ffn_w2": ffn_w2, "router": router, "moe_w1": moe_w1, "moe_w3": moe_w3,
            "moe_w2": moe_w2}


def reference(x, positions, norm_mix, norm_ffn, norm_final, w_in, conv_w, w_ret_out,
              w_conv_out, w_out, ffn_w1, ffn_w3, ffn_w2, router, moe_w1, moe_w3, moe_w2):
    bsz, t, _ = x.shape
    h = x
    for layer in range(DEPTH):
        xn = rmsnorm(h, norm_mix[layer])
        proj = xn @ w_in[layer]
        q, k, v, g, cb, cc, ch, ga, gb = jnp.split(proj, SPLIT_POINTS, axis=-1)
        q = rotary(q.reshape(bsz, t, RET_HEADS, RET_QK_DIM), positions) * (RET_QK_DIM ** -0.5)
        k = rotary(k.reshape(bsz, t, RET_HEADS, RET_QK_DIM), positions)
        v = v.reshape(bsz, t, RET_HEADS, RET_V_DIM).astype(jnp.float32)
        o = head_groupnorm(retention(q, k, v)).reshape(bsz, t, D_RV).astype(h.dtype)
        y_ret = (o * jax.nn.silu(g)) @ w_ret_out[layer]
        y_conv = (cb * causal_depthwise_conv(cc * ch, conv_w[layer])) @ w_conv_out[layer]
        merged = jax.nn.sigmoid(ga) * y_ret + jax.nn.sigmoid(gb) * y_conv
        h = h + merged @ w_out[layer]
        xn = rmsnorm(h, norm_ffn[layer])
        if layer % 2 == 0:
            i = layer // 2
            h = h + swiglu(xn, ffn_w1[i], ffn_w3[i], ffn_w2[i])
        else:
            i = layer // 2
            h = h + moe_swiglu(xn, router[i], moe_w1[i], moe_w3[i], moe_w2[i])
    return rmsnorm(h, norm_final)
```

```cpp
#include <hip/hip_runtime.h>
#include <stdio.h>

#ifndef MK_ONE_LAUNCH
#define MK_ONE_LAUNCH 1
#endif

#define LAS __attribute__((address_space(3)))
#define GAS __attribute__((address_space(1)))
typedef unsigned short bf16_t;
typedef short bf16x8 __attribute__((ext_vector_type(8)));
typedef short s16x4 __attribute__((ext_vector_type(4)));
typedef float f32x4 __attribute__((ext_vector_type(4)));
typedef float f32x2 __attribute__((ext_vector_type(2)));
typedef unsigned u32x4 __attribute__((ext_vector_type(4)));
typedef unsigned u32x2 __attribute__((ext_vector_type(2)));
typedef __bf16 bf2_t __attribute__((ext_vector_type(2)));
typedef int i32x8 __attribute__((ext_vector_type(8)));
typedef int i32x4 __attribute__((ext_vector_type(4)));
#define DI __device__ __forceinline__

constexpr int M_TOK = 16384, T_SEQ = 2048, D_MODEL = 2048, D_IN = 16384, D_FF = 5632, N_EXP = 8;
constexpr int MOE_MAX_ROWS = 34816;
constexpr float EPS = 1e-6f;

DI unsigned pk2(float lo, float hi) { f32x2 v = {lo, hi}; bf2_t r = __builtin_convertvector(v, bf2_t); return __builtin_bit_cast(unsigned, r); }
DI bf16_t f2bf(float f) { return (bf16_t)(pk2(f, 0.f) & 0xffffu); }
DI unsigned pk4_fp8(float a, float b, float c, float d) { int p = __builtin_amdgcn_cvt_pk_fp8_f32(a, b, 0, false); p = __builtin_amdgcn_cvt_pk_fp8_f32(c, d, p, true); return (unsigned)p; }
DI unsigned pk4_i8(float a, float b, float c, float d) {
    int qa = (int)__builtin_rintf(a), qb = (int)__builtin_rintf(b), qc = (int)__builtin_rintf(c), qd = (int)__builtin_rintf(d);
    qa = qa < -127 ? -127 : (qa > 127 ? 127 : qa); qb = qb < -127 ? -127 : (qb > 127 ? 127 : qb); qc = qc < -127 ? -127 : (qc > 127 ? 127 : qc); qd = qd < -127 ? -127 : (qd > 127 ? 127 : qd);
    return (unsigned)(qa & 255) | ((unsigned)(qb & 255) << 8) | ((unsigned)(qc & 255) << 16) | ((unsigned)qd << 24);
}
constexpr float I8_SX = 32.0f, I8_SM = 28.0f, I8_SH = 24.0f, I8_SG = 32.0f, I8_SW = 1408.0f;
DI unsigned pk4_u8(float a, float b, float c, float d) {
    return (unsigned)fmaxf(a * 255.0f + 0.5f, 1.0f) | ((unsigned)fmaxf(b * 255.0f + 0.5f, 1.0f) << 8) | ((unsigned)fmaxf(c * 255.0f + 0.5f, 1.0f) << 16) | ((unsigned)fmaxf(d * 255.0f + 0.5f, 1.0f) << 24);
}
DI f32x4 u8x4_f(unsigned w) { return (f32x4){(float)(w & 255u), (float)((w >> 8) & 255u), (float)((w >> 16) & 255u), (float)(w >> 24)} * (1.0f / 255.0f); }
DI float bf_lo(unsigned w) { return __builtin_bit_cast(float, w << 16); }
DI float bf_hi(unsigned w) { return __builtin_bit_cast(float, w & 0xffff0000u); }
DI float fsigmoid(float x) { return __builtin_amdgcn_rcpf(1.0f + __builtin_amdgcn_exp2f(-1.4426950408889634f * x)); }
DI float fsilu(float x) { return x * fsigmoid(x); }
DI float wave_sum(float v) {
#pragma unroll
    for (int o = 1; o < 64; o <<= 1) v += __shfl_xor(v, o);
    return v;
}
typedef float ss_t;
DI float ss_rstd(const ss_t* ss, int row) { const f32x4 a = *(const f32x4*)(ss + (size_t)row * 8), b = *(const f32x4*)(ss + (size_t)row * 8 + 4); return __builtin_amdgcn_rsqf((((a.x + a.y) + (a.z + a.w)) + ((b.x + b.y) + (b.z + b.w))) * (1.0f / 2048.0f) + EPS); }
DI float log2gamma(int h) { return h == 0 ? -0.04580368961312479f : (h == 1 ? -0.02272007650008353f : (h == 2 ? -0.011315313227834146f : -0.005646563141142063f)); }
#define LDS_WAIT() asm volatile("s_waitcnt lgkmcnt(0)" ::: "memory")
#define VM_WAIT() asm volatile("s_waitcnt vmcnt(0)" ::: "memory")

namespace pg8 {
constexpr int BM = 256, BK = 64, HALF = 128, HTB = HALF * BK * 2, STAGE_BYTES = 8 * HTB, NXCD = 8, WGM = 8;
DI int lds_byte(int r, int c) { const int st = (r >> 4) * 2 + (c >> 5), rr = r & 15, cc = c & 31, ob = rr * 64 + cc * 2; return st * 1024 + (ob ^ (((ob >> 9) & 1) << 5)); }
DI void stage_rc(int b, int& R, int& C) { const int st = b / 1024, sb = b % 1024, swz = sb ^ (((sb >> 9) & 1) << 5); R = (st >> 1) * 16 + swz / 64; C = (st & 1) * 32 + (swz % 64) / 2; }
DI int perm32(int rho) { const int n = rho >> 4, i = rho & 15; return 8 * (i >> 2) + 4 * n + (i & 3); }

struct Unit { int pm, pn, pb, pa; };
struct Gemm { const void* A; const void* Bt; int Kb; };

DI void order_map(int L, int nM, int nN, int& pm, int& pn) {
    const int nwg = nM * nN;
    int wgid = L; { const int q = nwg / NXCD, r = nwg % NXCD, xcd = wgid % NXCD, off = wgid / NXCD; wgid = (xcd < r ? xcd * (q + 1) : r * (q + 1) + (xcd - r) * q) + off; }
    const int nig = WGM * nN, gid = wgid / nig, fm = gid * WGM, gsz = (nM - fm) < WGM ? (nM - fm) : WGM;
    pm = fm + ((wgid % nig) % gsz); pn = (wgid % nig) / gsz;
}
struct StaticOrder {
    int nM, nN, nwg, G, c;
    DI void init(int nM_, int nN_, int G_, int c_) { nM = nM_; nN = nN_; nwg = nM * nN; G = G_; c = c_; }
    DI bool next(int i, Unit& u) const {
        const long L = (long)i * G + c; if (L >= nwg) return false;
        order_map((int)L, nM, nN, u.pm, u.pn); u.pb = u.pn; u.pa = u.pm; return true;
    }
    DI void a_ready(const Unit&) const {}
    DI void done(const Unit&) const {}
};
DI void order_panel(int L, int nM, int nN, int& pm, int& pn) {
    const int nwg = nM * nN;
    int wgid = L; { const int q = nwg / NXCD, r = nwg % NXCD, xcd = wgid % NXCD, off = wgid / NXCD; wgid = (xcd < r ? xcd * (q + 1) : r * (q + 1) + (xcd - r) * q) + off; }
    pm = wgid / nN; pn = wgid - pm * nN;
}
struct MoeOrder {
    int nN, G, c; int tb1, tb2, tb3, tb4, tb5, tb6, tb7, tb8; int sparse_a;
    unsigned* donep;
    DI bool next(int i, Unit& u) const {
        const long L = (long)i * G + c; const int nM = tb8; if (L >= (long)nM * nN) return false;
        if (donep) order_panel((int)L, nM, nN, u.pm, u.pn); else order_map((int)L, nM, nN, u.pm, u.pn);
        const int pm = u.pm;
        const int e = (pm >= tb1) + (pm >= tb2) + (pm >= tb3) + (pm >= tb4) + (pm >= tb5) + (pm >= tb6) + (pm >= tb7);
        const int tbe = e == 0 ? 0 : e == 1 ? tb1 : e == 2 ? tb2 : e == 3 ? tb3 : e == 4 ? tb4 : e == 5 ? tb5 : e == 6 ? tb6 : tb7;
        u.pb = e * nN + u.pn; u.pa = sparse_a ? e * 64 + (pm - tbe) : pm; return true;
    }
    DI void a_ready(const Unit&) const {}
    DI void done(const Unit& u) const {
        if (donep) { asm volatile("s_waitcnt vmcnt(0)" ::: "memory");
            if ((threadIdx.x & 63) == 0) __hip_atomic_fetch_add(donep + 16 * u.pm, 1u, __ATOMIC_RELAXED, __HIP_MEMORY_SCOPE_AGENT); }
    }
};
struct PairOrder {
    int G, c, wofs;
    DI bool next(int i, Unit& u) const {
        const long L = (long)(i >> 1) * G + c; if (L >= 64 * 8) return false;
        order_map((int)L, 64, 8, u.pm, u.pn); const int sub = i & 1; u.pa = u.pm + 64 * sub; u.pb = wofs + u.pn + 16 * sub; return true;
    }
    DI void a_ready(const Unit&) const {}
    DI void done(const Unit&) const {}
};

template <int MM = 0  , class Epi, class Sched, bool ALIGN_EPI = true, bool SP2 = true>
DI void gemm_phase(LAS unsigned char* lds, const Gemm g, const Sched& S, const Epi& E) {
    int tid_ = threadIdx.x; asm volatile("" : "+v"(tid_));
    const int tid = tid_, wid = __builtin_amdgcn_readfirstlane(tid >> 6), lane = tid & 63, wr = wid >> 2, wc = wid & 3, fr = lane & 15, fq = lane >> 4;
    constexpr bool FP8 = (MM == 1), I8 = (MM == 2);
    const int Kb = g.Kb, nt = Kb / (BK * 2);
    unsigned voffA[2], voffB[2];
#pragma unroll
    for (int i = 0; i < 2; ++i) { int R, C; stage_rc(tid * 16 + i * 8192, R, C); const int Rb = Epi::PERM ? ((R & ~31) + perm32(R & 31)) : R;
        voffA[i] = (unsigned)(R * Kb + C * 2); voffB[i] = (unsigned)(Rb * Kb + C * 2); }
    const size_t kstep = (size_t)(BK * 2);
    const size_t hstep = (size_t)HALF * Kb;
    const size_t tstep = 2 * hstep;
    const unsigned ldsw = (unsigned)wid * 1024u;
    const int aoff = lds_byte(wr * 64 + fr, fq * 8), boff = lds_byte(wc * 32 + fr, fq * 8);
#define PG8_SA(b, h) (((b) * 2 + (h)) * HTB)
#define PG8_SB(b, h) ((4 + (b) * 2 + (h)) * HTB)
#define PG8_STAGE(bufoff, gbase, voff) do { _Pragma("unroll") for (int _i = 0; _i < 2; ++_i) \
        __builtin_amdgcn_global_load_lds((const unsigned*)((const char*)(gbase) + (voff)[_i]), (LAS unsigned*)(lds + (bufoff) + ldsw + _i * 8192), 16, 0, 0); } while (0)
#define PG8_LDA(dst, b, h) do { _Pragma("unroll") for (int m = 0; m < 4; ++m) _Pragma("unroll") for (int k = 0; k < 2; ++k) dst[m][k] = *(const LAS bf16x8*)(lds + PG8_SA(b, h) + aoff + m * 2048 + k * 1024); } while (0)
#define PG8_LDB(dst, b, h) do { _Pragma("unroll") for (int n = 0; n < 2; ++n) _Pragma("unroll") for (int k = 0; k < 2; ++k) dst[n][k] = *(const LAS bf16x8*)(lds + PG8_SB(b, h) + boff + n * 2048 + k * 1024); } while (0)
#define PG8_MMA(ai, bj, At, Bt) do { __builtin_amdgcn_s_setprio(3); _Pragma("unroll") for (int m = 0; m < 4; ++m) _Pragma("unroll") for (int n = 0; n < 2; ++n) { \
        if constexpr (FP8) { const i32x8 bb = __builtin_shufflevector(__builtin_bit_cast(i32x4, Bt[n][0]), __builtin_bit_cast(i32x4, Bt[n][1]), 0, 1, 2, 3, 4, 5, 6, 7); \
                             const i32x8 aa = __builtin_shufflevector(__builtin_bit_cast(i32x4, At[m][0]), __builtin_bit_cast(i32x4, At[m][1]), 0, 1, 2, 3, 4, 5, 6, 7); \
                             asm volatile("v_mfma_scale_f32_16x16x128_f8f6f4 %0, %1, %2, %0, %3, %3 op_sel_hi:[0,0,0]" : "+v"(acc[ai][bj][m][n]) : "v"(bb), "v"(aa), "v"(sc8)); } \
        else if constexpr (I8) { _Pragma("unroll") for (int k = 0; k < 2; ++k) acc[ai][bj][m][n] = __builtin_bit_cast(f32x4, __builtin_amdgcn_mfma_i32_16x16x64_i8(__builtin_bit_cast(i32x4, Bt[n][k]), __builtin_bit_cast(i32x4, At[m][k]), __builtin_bit_cast(i32x4, acc[ai][bj][m][n]), 0, 0, 0)); } \
        else { _Pragma("unroll") for (int k = 0; k < 2; ++k) acc[ai][bj][m][n] = __builtin_amdgcn_mfma_f32_16x16x32_bf16(Bt[n][k], At[m][k], acc[ai][bj][m][n], 0, 0, 0); } } \
        __builtin_amdgcn_s_setprio(0); } while (0)
#define PG8_WAIT_V(n) asm volatile("s_waitcnt vmcnt(" #n ")" ::: "memory")
#define PG8_WAIT_L(n) asm volatile("s_waitcnt lgkmcnt(" #n ")" ::: "memory")
#define PG8_BAR __builtin_amdgcn_s_barrier()
#define PG8_SCHED __builtin_amdgcn_sched_barrier(0)
    int sc8 = 0x7f7f7f7f; if constexpr (FP8) asm volatile("" : "+v"(sc8));
    (void)sc8;
    Unit cur, nxt; int ui = 0;
    if (!S.next(0, cur)) return;
    f32x4 acc[2][2][4][2];
#pragma unroll
    for (int a = 0; a < 2; ++a)
#pragma unroll
        for (int b = 0; b < 2; ++b)
#pragma unroll
            for (int m = 0; m < 4; ++m)
#pragma unroll
                for (int n = 0; n < 2; ++n) acc[a][b][m][n] = (f32x4){0.f, 0.f, 0.f, 0.f};
    bf16x8 At[4][2], B0[2][2], B1[2][2];
    const char* cA = (const char*)g.A + (size_t)cur.pa * tstep; const char* cB = (const char*)g.Bt + (size_t)cur.pb * tstep;
    S.a_ready(cur);
    if constexpr (SP2) {
        PG8_STAGE(PG8_SB(0, 0), cB, voffB); PG8_STAGE(PG8_SB(0, 1), cB + hstep, voffB); PG8_STAGE(PG8_SA(0, 0), cA, voffA); PG8_STAGE(PG8_SA(0, 1), cA + hstep, voffA);
        if (wr == 1) PG8_BAR;
        PG8_WAIT_V(2); PG8_BAR;
        PG8_STAGE(PG8_SB(1, 0), cB + kstep, voffB); PG8_STAGE(PG8_SA(1, 0), cA + kstep, voffA); PG8_STAGE(PG8_SB(1, 1), cB + hstep + kstep, voffB);
        PG8_WAIT_V(6); PG8_BAR;
    } else {
        PG8_STAGE(PG8_SB(0, 0), cB, voffB); PG8_STAGE(PG8_SA(0, 0), cA, voffA); PG8_STAGE(PG8_SB(0, 1), cB + hstep, voffB); PG8_STAGE(PG8_SA(0, 1), cA + hstep, voffA);
        if (wr == 1) PG8_BAR;
        PG8_WAIT_V(4); PG8_BAR;
        PG8_STAGE(PG8_SB(1, 0), cB + kstep, voffB); PG8_STAGE(PG8_SA(1, 0), cA + kstep, voffA); PG8_STAGE(PG8_SB(1, 1), cB + hstep + kstep, voffB);
        PG8_WAIT_V(6); PG8_BAR;
    }
    for (;;) {
        const bool has_next = S.next(ui + 1, nxt);
        const char* nA = has_next ? (const char*)g.A + (size_t)nxt.pa * tstep : cA; const char* nB = has_next ? (const char*)g.Bt + (size_t)nxt.pb * tstep : cB;
        for (int t = 0; t < nt; t += 2) {
            const bool last = (t == nt - 2);
            const char* a1 = cA + (size_t)(t + 1) * kstep;
            const char* a2 = last ? nA : cA + (size_t)(t + 2) * kstep; const char* b2 = last ? nB : cB + (size_t)(t + 2) * kstep;
            const char* a3 = a2 + kstep; const char* b3 = b2 + kstep;
            if (last && has_next) S.a_ready(nxt);
            if constexpr (SP2) {
            PG8_LDB(B0, 0, 0); PG8_LDB(B1, 0, 1); PG8_SCHED; PG8_LDA(At, 0, 0); PG8_STAGE(PG8_SA(1, 1), a1 + hstep, voffA);
            PG8_WAIT_V(8); PG8_WAIT_L(0); PG8_BAR; PG8_MMA(0, 0, At, B0); PG8_MMA(0, 1, At, B1); PG8_BAR; PG8_SCHED;
            PG8_LDA(At, 0, 1); PG8_STAGE(PG8_SB(0, 0), b2, voffB); PG8_STAGE(PG8_SB(0, 1), b2 + hstep, voffB); PG8_STAGE(PG8_SA(0, 0), a2, voffA);
            PG8_WAIT_V(8); PG8_WAIT_L(0); PG8_BAR; PG8_MMA(1, 0, At, B0); PG8_MMA(1, 1, At, B1); PG8_BAR; PG8_SCHED;
            PG8_LDB(B0, 1, 0); PG8_LDB(B1, 1, 1); PG8_SCHED; PG8_LDA(At, 1, 0); PG8_STAGE(PG8_SA(0, 1), a2 + hstep, voffA);
            PG8_WAIT_V(8); PG8_WAIT_L(0); PG8_BAR; PG8_MMA(0, 0, At, B0); PG8_MMA(0, 1, At, B1); PG8_BAR; PG8_SCHED;
            PG8_LDA(At, 1, 1); PG8_STAGE(PG8_SB(1, 0), b3, voffB); PG8_STAGE(PG8_SB(1, 1), b3 + hstep, voffB); PG8_STAGE(PG8_SA(1, 0), a3, voffA);
            PG8_WAIT_V(8); PG8_WAIT_L(0); PG8_BAR; PG8_MMA(1, 0, At, B0); PG8_MMA(1, 1, At, B1); PG8_BAR; PG8_SCHED;
            } else {
            PG8_LDB(B0, 0, 0); PG8_SCHED; PG8_LDA(At, 0, 0); PG8_STAGE(PG8_SA(1, 1), a1 + hstep, voffA);
            PG8_WAIT_L(8); PG8_BAR; PG8_WAIT_L(0); PG8_MMA(0, 0, At, B0); PG8_BAR; PG8_SCHED;
            PG8_LDB(B1, 0, 1); PG8_STAGE(PG8_SB(0, 0), b2, voffB);
            PG8_BAR; PG8_WAIT_L(0); PG8_MMA(0, 1, At, B1); PG8_BAR;
            PG8_LDA(At, 0, 1); PG8_STAGE(PG8_SA(0, 0), a2, voffA);
            PG8_BAR; PG8_WAIT_L(0); PG8_MMA(1, 0, At, B0); PG8_BAR; PG8_SCHED;
            PG8_STAGE(PG8_SB(0, 1), b2 + hstep, voffB);
            PG8_WAIT_V(6); PG8_BAR; PG8_MMA(1, 1, At, B1); PG8_BAR;
            PG8_LDB(B0, 1, 0); PG8_SCHED; PG8_LDA(At, 1, 0); PG8_STAGE(PG8_SA(0, 1), a2 + hstep, voffA);
            PG8_WAIT_L(8); PG8_BAR; PG8_WAIT_L(0); PG8_MMA(0, 0, At, B0); PG8_BAR; PG8_SCHED;
            PG8_LDB(B1, 1, 1); PG8_STAGE(PG8_SB(1, 0), b3, voffB);
            PG8_BAR; PG8_WAIT_L(0); PG8_MMA(0, 1, At, B1); PG8_BAR;
            PG8_LDA(At, 1, 1); PG8_STAGE(PG8_SA(1, 0), a3, voffA);
            PG8_BAR; PG8_WAIT_L(0); PG8_MMA(1, 0, At, B0); PG8_BAR; PG8_SCHED;
            PG8_STAGE(PG8_SB(1, 1), b3 + hstep, voffB);
            PG8_WAIT_V(6); PG8_BAR; PG8_MMA(1, 1, At, B1); PG8_BAR;
            }
        }
        if constexpr (FP8) asm volatile("s_nop 15\n\ts_nop 7" ::: "memory");
        if constexpr (ALIGN_EPI) { if (wr == 0) PG8_BAR; }
        if constexpr (I8) {
#pragma unroll
            for (int a = 0; a < 2; ++a)
#pragma unroll
                for (int b = 0; b < 2; ++b)
#pragma unroll
                    for (int m = 0; m < 4; ++m)
#pragma unroll
                        for (int n = 0; n < 2; ++n) acc[a][b][m][n] = __builtin_convertvector(__builtin_bit_cast(i32x4, acc[a][b][m][n]), f32x4);
        }
        E(acc, cur, wr, wc, fr, fq); S.done(cur);
        if (!has_next) break;
        if (!(Epi::PAIR && (ui & 1) == 0)) {
#pragma unroll
        for (int a = 0; a < 2; ++a)
#pragma unroll
            for (int b = 0; b < 2; ++b)
#pragma unroll
                for (int m = 0; m < 4; ++m)
#pragma unroll
                    for (int n = 0; n < 2; ++n) acc[a][b][m][n] = (f32x4){0.f, 0.f, 0.f, 0.f};
        }
        cur = nxt; cA = nA; cB = nB; ++ui;
        if constexpr (ALIGN_EPI) { if (wr == 1) PG8_BAR; }
    }
    PG8_WAIT_V(0);
    if constexpr (!ALIGN_EPI) { if (wr == 0) PG8_BAR; }
    PG8_BAR;
#undef PG8_SA
#undef PG8_SB
#undef PG8_STAGE
#undef PG8_LDA
#undef PG8_LDB
#undef PG8_MMA
#undef PG8_WAIT_V
#undef PG8_WAIT_L
#undef PG8_BAR
#undef PG8_SCHED
}

DI u32x4 pack8(const f32x4 a, const f32x4 b) { u32x4 w; w.x = pk2(a[0], a[1]); w.y = pk2(a[2], a[3]); w.z = pk2(b[0], b[1]); w.w = pk2(b[2], b[3]); return w; }
DI void unpack8(const u32x4 w, f32x4& a, f32x4& b) { a = (f32x4){bf_lo(w.x), bf_hi(w.x), bf_lo(w.y), bf_hi(w.y)}; b = (f32x4){bf_lo(w.z), bf_hi(w.z), bf_lo(w.w), bf_hi(w.w)}; }

struct EpiInProj {
    static constexpr bool PERM = true, PAIR = false;
    bf16_t *Q, *Kk, *V, *SG, *CB, *U, *SGA, *SGB; const float *tabc, *tabs; const ss_t* ss; float sc;
    template <int ACT> DI void plain(const f32x4 (&acc)[2][2][4][2], bf16_t* dst, int row0, int col0) const {
#pragma unroll
        for (int ai = 0; ai < 2; ++ai)
#pragma unroll
            for (int m = 0; m < 4; ++m) { bf16_t* rowp = dst + (size_t)(row0 + ai * 128 + m * 16) * 2048 + col0;
#pragma unroll
                for (int bj = 0; bj < 2; ++bj) { f32x4 v0 = acc[ai][bj][m][0], v1 = acc[ai][bj][m][1];
                    if (ACT == 1) {
#pragma unroll
                        for (int j = 0; j < 4; ++j) { v0[j] = fsilu(v0[j]); v1[j] = fsilu(v1[j]); } }
                    if (ACT == 2) {
#pragma unroll
                        for (int j = 0; j < 4; ++j) { v0[j] = fsigmoid(v0[j]); v1[j] = fsigmoid(v1[j]); } }
                    *(u32x4*)(rowp + bj * 128) = pack8(v0, v1); } }
    }
    DI void operator()(f32x4 (&acc)[2][2][4][2], const Unit& u, int wr, int wc, int fr, int fq) const {
        const int pn = u.pn, row0 = u.pm * 256 + wr * 64 + fr, cl = wc * 32 + 8 * fq;
        {
            float rs[2][4];
#pragma unroll
            for (int ai = 0; ai < 2; ++ai)
#pragma unroll
                for (int m = 0; m < 4; ++m) rs[ai][m] = ss_rstd(ss, row0 + ai * 128 + m * 16) * sc;
#pragma unroll
            for (int ai = 0; ai < 2; ++ai)
#pragma unroll
                for (int m = 0; m < 4; ++m)
#pragma unroll
                    for (int bj = 0; bj < 2; ++bj) { acc[ai][bj][m][0] = acc[ai][bj][m][0] * rs[ai][m]; acc[ai][bj][m][1] = acc[ai][bj][m][1] * rs[ai][m]; }
        }
        if (pn < 8) {
            const bool isq = pn < 4; const int hh = pn & 3; bf16_t* dst = (isq ? Q : Kk) + hh * 256 + cl; const float l2g = log2gamma(hh);
#pragma unroll
            for (int ai = 0; ai < 2; ++ai) {
                f32x4 cs[4][4];
#pragma unroll
                for (int m = 0; m < 4; ++m) { const int row = row0 + ai * 128 + m * 16; const float* cp = tabc + (size_t)row * 128 + cl; const float* sp = tabs + (size_t)row * 128 + cl;
                    cs[m][0] = *(const f32x4*)cp; cs[m][1] = *(const f32x4*)(cp + 4); cs[m][2] = *(const f32x4*)sp; cs[m][3] = *(const f32x4*)(sp + 4); }
#pragma unroll
                for (int m = 0; m < 4; ++m) { const int row = row0 + ai * 128 + m * 16; const float tc1 = (float)(wr * 64 + m * 16 + fr + 1);
                    const float sc = isq ? 0.0625f * __builtin_amdgcn_exp2f(tc1 * l2g) : __builtin_amdgcn_exp2f(-tc1 * l2g);
                    const f32x4 c0 = cs[m][0], c1 = cs[m][1], s0 = cs[m][2], s1 = cs[m][3];
                    const f32x4 x1a = acc[ai][0][m][0], x1b = acc[ai][0][m][1], x2a = acc[ai][1][m][0], x2b = acc[ai][1][m][1];
                    const f32x4 o1a = (x1a * c0 - x2a * s0) * sc, o1b = (x1b * c1 - x2b * s1) * sc, o2a = (x1a * s0 + x2a * c0) * sc, o2b = (x1b * s1 + x2b * c1) * sc;
                    bf16_t* rowp = dst + (size_t)row * 1024;
                    *(u32x4*)rowp = pack8(o1a, o1b); *(u32x4*)(rowp + 128) = pack8(o2a, o2b); }
            }
        } else if (pn >= 32 && pn < 48) {
            bf16_t* dst = U + (pn - 32) * 128 + cl;
#pragma unroll
            for (int ai = 0; ai < 2; ++ai)
#pragma unroll
                for (int m = 0; m < 4; ++m) { const int row = row0 + ai * 128 + m * 16;
                    *(u32x4*)(dst + (size_t)row * 2048) = pack8(acc[ai][0][m][0] * acc[ai][1][m][0], acc[ai][0][m][1] * acc[ai][1][m][1]); }
        } else if (pn < 16) plain<0>(acc, V, row0, (pn - 8) * 256 + cl);
        else if (pn < 24) plain<1>(acc, SG, row0, (pn - 16) * 256 + cl);
        else if (pn < 32) plain<0>(acc, CB, row0, (pn - 24) * 256 + cl);
        else {
            unsigned char* dst = (unsigned char*)(pn < 56 ? SGA : SGB) + ((pn - 48) & 7) * 256 + cl;
#pragma unroll
            for (int ai = 0; ai < 2; ++ai)
#pragma unroll
                for (int m = 0; m < 4; ++m) { unsigned char* rowp = dst + (size_t)(row0 + ai * 128 + m * 16) * 2048;
#pragma unroll
                    for (int bj = 0; bj < 2; ++bj) { const f32x4 v0 = acc[ai][bj][m][0], v1 = acc[ai][bj][m][1]; u32x2 w;
                        w.x = pk4_u8(fsigmoid(v0[0]), fsigmoid(v0[1]), fsigmoid(v0[2]), fsigmoid(v0[3])); w.y = pk4_u8(fsigmoid(v1[0]), fsigmoid(v1[1]), fsigmoid(v1[2]), fsigmoid(v1[3]));
                        *(u32x2*)(rowp + bj * 128) = w; } }
        }
    }
};
struct EpiGatePair {
    static constexpr bool PERM = true, PAIR = true;
    const unsigned char *ga, *gb; unsigned char* out8;
    DI void operator()(f32x4 (&acc)[2][2][4][2], const Unit& u, int wr, int wc, int fr, int fq) const {
        const int row0 = u.pm * 256 + wr * 64 + fr, col0 = u.pn * 256 + wc * 32 + 8 * fq;
        const bool first = u.pa < 64;
#pragma unroll
        for (int ai = 0; ai < 2; ++ai) {
            u32x2 av[4][2], bv[4][2];
#pragma unroll
            for (int m = 0; m < 4; ++m)
#pragma unroll
                for (int bj = 0; bj < 2; ++bj) { const size_t off = (size_t)(row0 + ai * 128 + m * 16) * 2048 + col0 + bj * 128;
                    bv[m][bj] = *(const u32x2*)(gb + off); if (first) av[m][bj] = *(const u32x2*)(ga + off); }
            if (first) {
#pragma unroll
                for (int m = 0; m < 4; ++m)
#pragma unroll
                    for (int bj = 0; bj < 2; ++bj) {
                        const f32x4 a0 = u8x4_f(av[m][bj].x), a1 = u8x4_f(av[m][bj].y), b0 = u8x4_f(bv[m][bj].x), b1 = u8x4_f(bv[m][bj].y);
                        f32x4 r0, r1;
#pragma unroll
                        for (int j = 0; j < 4; ++j) { r0[j] = a0[j] * __builtin_amdgcn_rcpf(b0[j]); r1[j] = a1[j] * __builtin_amdgcn_rcpf(b1[j]); }
                        acc[ai][bj][m][0] = acc[ai][bj][m][0] * r0; acc[ai][bj][m][1] = acc[ai][bj][m][1] * r1; }
            } else {
#pragma unroll
                for (int m = 0; m < 4; ++m)
#pragma unroll
                    for (int bj = 0; bj < 2; ++bj) { const size_t off = (size_t)(row0 + ai * 128 + m * 16) * 2048 + col0 + bj * 128;
                        const f32x4 v0 = acc[ai][bj][m][0] * u8x4_f(bv[m][bj].x) * I8_SG, v1 = acc[ai][bj][m][1] * u8x4_f(bv[m][bj].y) * I8_SG;
                        u32x2 w8; w8.x = pk4_i8(v0[0], v0[1], v0[2], v0[3]); w8.y = pk4_i8(v1[0], v1[1], v1[2], v1[3]); *(u32x2*)(out8 + off) = w8; }
            }
        }
    }
};
template <bool BASE_F32> struct EpiResidB {
    static constexpr bool PERM = true, PAIR = false;
    const void* base; bf16_t* out; ss_t* ss; LAS float* red; unsigned char* out8; float s8, sc;
    DI void operator()(const f32x4 (&acc)[2][2][4][2], const Unit& u, int wr, int wc, int fr, int fq) const {
        const int row0 = u.pm * 256 + wr * 64 + fr, col0 = u.pn * 256 + wc * 32 + 8 * fq;
#pragma unroll
        for (int ai = 0; ai < 2; ++ai) {
            f32x4 b0[4][2], b1[4][2];
#pragma unroll
            for (int m = 0; m < 4; ++m)
#pragma unroll
                for (int bj = 0; bj < 2; ++bj) { const size_t off = (size_t)(row0 + ai * 128 + m * 16) * 2048 + col0 + bj * 128;
                    if (BASE_F32) { b0[m][bj] = *(const f32x4*)((const float*)base + off); b1[m][bj] = *(const f32x4*)((const float*)base + off + 4); }
                    else unpack8(*(const u32x4*)((const bf16_t*)base + off), b0[m][bj], b1[m][bj]); }
#pragma unroll
            for (int m = 0; m < 4; ++m) { float s = 0.f;
#pragma unroll
                for (int bj = 0; bj < 2; ++bj) { const size_t off = (size_t)(row0 + ai * 128 + m * 16) * 2048 + col0 + bj * 128;
                    const f32x4 v0 = b0[m][bj] + acc[ai][bj][m][0] * sc, v1 = b1[m][bj] + acc[ai][bj][m][1] * sc;
                    s += (v0[0] * v0[0] + v0[1] * v0[1]) + (v0[2] * v0[2] + v0[3] * v0[3]) + (v1[0] * v1[0] + v1[1] * v1[1]) + (v1[2] * v1[2] + v1[3] * v1[3]);
                    *(u32x4*)(out + off) = pack8(v0, v1);
                    if (out8) { const f32x4 q0 = v0 * s8, q1 = v1 * s8; u32x2 w8; w8.x = pk4_i8(q0[0], q0[1], q0[2], q0[3]); w8.y = pk4_i8(q1[0], q1[1], q1[2], q1[3]); *(u32x2*)(out8 + off) = w8; } }
                s += __shfl_xor(s, 16); s += __shfl_xor(s, 32);
                if (fq == 0) red[(ai * 128 + wr * 64 + m * 16 + fr) * 4 + wc] = s; }
        }
        asm volatile("s_waitcnt lgkmcnt(0)" ::: "memory"); __builtin_amdgcn_s_barrier(); asm volatile("" ::: "memory");
        { const int t = (wr * 4 + wc) * 64 + fq * 16 + fr; if (t < 256) { const f32x4 p = *(const LAS f32x4*)(red + t * 4); ss[(size_t)(u.pm * 256 + t) * 8 + u.pn] = (p.x + p.y) + (p.z + p.w); } }
    }
};
struct EpiSwiglu {
    static constexpr bool PERM = true, PAIR = false;
    bf16_t* out; const ss_t* ss; float sc;
    DI void operator()(const f32x4 (&acc)[2][2][4][2], const Unit& u, int wr, int wc, int fr, int fq) const {
        const int row0 = u.pm * 256 + wr * 64 + fr; bf16_t* dst = out + u.pn * 128 + wc * 32 + 8 * fq;
        float rsv[2][4];
#pragma unroll
        for (int ai = 0; ai < 2; ++ai)
#pragma unroll
            for (int m = 0; m < 4; ++m) rsv[ai][m] = ss_rstd(ss, row0 + ai * 128 + m * 16) * sc;
#pragma unroll
        for (int ai = 0; ai < 2; ++ai)
#pragma unroll
            for (int m = 0; m < 4; ++m) { const int row = row0 + ai * 128 + m * 16; const float rs = rsv[ai][m];
                f32x4 a0 = acc[ai][0][m][0] * rs, a1 = acc[ai][0][m][1] * rs;
#pragma unroll
                for (int j = 0; j < 4; ++j) { a0[j] = fsilu(a0[j]); a1[j] = fsilu(a1[j]); }
                *(u32x4*)(dst + (size_t)row * D_FF) = pack8(a0 * (acc[ai][1][m][0] * rs), a1 * (acc[ai][1][m][1] * rs)); }
    }
};
struct EpiSwiglu8 {
    static constexpr bool PERM = true, PAIR = false;
    unsigned char* out; float sc;
    DI void operator()(const f32x4 (&acc)[2][2][4][2], const Unit& u, int wr, int wc, int fr, int fq) const {
        const int row0 = u.pm * 256 + wr * 64 + fr; unsigned char* dst = out + u.pn * 128 + wc * 32 + 8 * fq;
#pragma unroll
        for (int ai = 0; ai < 2; ++ai)
#pragma unroll
            for (int m = 0; m < 4; ++m) { f32x4 a0 = acc[ai][0][m][0] * sc, a1 = acc[ai][0][m][1] * sc;
#pragma unroll
                for (int j = 0; j < 4; ++j) { a0[j] = fsilu(a0[j]); a1[j] = fsilu(a1[j]); }
                a0 = a0 * (acc[ai][1][m][0] * sc); a1 = a1 * (acc[ai][1][m][1] * sc);
                u32x2 w; w.x = pk4_fp8(a0[0], a0[1], a0[2], a0[3]); w.y = pk4_fp8(a1[0], a1[1], a1[2], a1[3]);
                *(u32x2*)(dst + (size_t)(row0 + ai * 128 + m * 16) * D_FF) = w; }
    }
};
struct EpiBf16PlainWT {
    static constexpr bool PERM = true, PAIR = false;
    bf16_t* out; float sc;
    DI void operator()(const f32x4 (&acc)[2][2][4][2], const Unit& u, int wr, int wc, int fr, int fq) const {
        const int row0 = u.pm * 256 + wr * 64 + fr, col0 = u.pn * 256 + wc * 32 + 8 * fq;
        const __amdgpu_buffer_rsrc_t rs = __builtin_amdgcn_make_buffer_rsrc((void*)out, 0, MOE_MAX_ROWS * 2048 * 2, 0x00020000);
#pragma unroll
        for (int ai = 0; ai < 2; ++ai)
#pragma unroll
            for (int m = 0; m < 4; ++m) { const unsigned rowb = (unsigned)(((row0 + ai * 128 + m * 16) * 2048 + col0) * 2);
#pragma unroll
                for (int bj = 0; bj < 2; ++bj) __builtin_amdgcn_raw_buffer_store_b128(pack8(acc[ai][bj][m][0] * sc, acc[ai][bj][m][1] * sc), rs, rowb + bj * 256, 0,   16); }
    }
};
}

constexpr size_t MiB = 1u << 20;
constexpr size_t WS_CTL = 0, CTL_ZERO_BYTES = 64 * 1024;
constexpr size_t WS_RT_E = 1 * MiB, WS_RT_POS = WS_RT_E + 128 * 1024, WS_RT_G = WS_RT_POS + 128 * 1024, WS_RT_ROW = WS_RT_G + 128 * 1024;
constexpr size_t WS_TABC = 2 * MiB, WS_TABS = 10 * MiB;
constexpr size_t WS_WIN8 = 18 * MiB, WS_M8 = 82 * MiB, WS_WRET = 146 * MiB, WS_WCONV = 162 * MiB, WS_WOUT = 178 * MiB, WS_W13 = 194 * MiB, WS_W2 = 238 * MiB, WS_MW13 = 260 * MiB, WS_MW2 = 436 * MiB;
constexpr size_t WS_XN = 524 * MiB;
constexpr size_t WS_Q = 588 * MiB, WS_K = 620 * MiB, WS_V = 652 * MiB, WS_SG = 716 * MiB, WS_CB = 780 * MiB, WS_U = 844 * MiB, WS_SGA = 908 * MiB, WS_SGB = 972 * MiB;
constexpr size_t WS_XGS = 780 * MiB;
constexpr size_t WS_ACT = 588 * MiB;
constexpr size_t WS_ORAW = 1036 * MiB, WS_XG = 1100 * MiB, WS_HB = 1236 * MiB, WS_SS = 1300 * MiB, WS_X8 = 1302 * MiB, WS_HB8 = 1334 * MiB, WS_END = 1366 * MiB;
static_assert(WS_MW13 + 8ull * 11264 * 2048 <= WS_MW2 && WS_MW2 + 8ull * 2048 * 5632 <= WS_XN && WS_XGS == WS_CB && WS_XGS + 8ull * 16384 * 2048 <= WS_ORAW && WS_SGB + 64 * MiB <= WS_ORAW && WS_CB == WS_SG + 64 * MiB && WS_WCONV == WS_WRET + 16 * MiB, "d_ws map");
static_assert(WS_ACT + (size_t)M_TOK * D_FF * 2 <= WS_ORAW && WS_ACT + (size_t)MOE_MAX_ROWS * D_FF <= WS_ORAW, "ACT overlay");
constexpr float W8_SCALE = 64.0f;
static_assert(WS_XG + (size_t)MOE_MAX_ROWS * D_MODEL * 2 <= WS_END, "XG");
constexpr int CW_CNT = 1024;
constexpr int CW_BAR = 4096;
constexpr int CW_DONE = 8192;
constexpr unsigned DONE_NEED = 64u;

constexpr int RING_BYTES = 131072, MISC_OFF = RING_BYTES, LDS_BYTES = RING_BYTES + 1024 + 4096;

#define XB_TMO      128
#define XB_XCNT(j)  (256  + 64 * (j))
#define XB_XSUB(j)  (1280 + 64 * (j))
#define XB_XGEN(j)  (2304 + 64 * (j))
#define XB_TOP      3328
#define XB_TOPGEN   3392
#define XCD_BAR_WORDS 3456
#define XB_SPIN_CAP (1u << 18)
DI unsigned xb_ld(unsigned* p)              { return __hip_atomic_load(p, __ATOMIC_RELAXED, __HIP_MEMORY_SCOPE_AGENT); }
DI unsigned xb_add(unsigned* p, unsigned v) { return __hip_atomic_fetch_add(p, v, __ATOMIC_RELAXED, __HIP_MEMORY_SCOPE_AGENT); }
DI unsigned xb_xcc_id() { return (unsigned)__builtin_amdgcn_s_getreg((3 << 11) | 20) & 0xFu; }
#define XB_SPIN(cond, bar) do { unsigned _sp = 0; while (cond) { __builtin_amdgcn_s_sleep(1); \
    if ((++_sp & 255u) == 0u) { if (xb_ld(&(bar)[XB_TMO])) break; if (_sp > XB_SPIN_CAP) { atomicAdd(&(bar)[XB_TMO], 1u); break; } } } } while (0)
struct XcdBarrier { unsigned* bar; unsigned x; volatile LAS unsigned* st; };
DI XcdBarrier xcd_barrier_post(unsigned* bar, volatile LAS unsigned* st) {
    XcdBarrier b; b.bar = bar; b.x = xb_xcc_id(); b.st = st;
    if (threadIdx.x == 0) (void)xb_add(&bar[XB_XCNT(b.x)], 1u);
    return b;
}
DI void xcd_barrier_complete(unsigned* bar, unsigned x, unsigned& nloc, unsigned& nx) {
    const unsigned G = gridDim.x * gridDim.y * gridDim.z;
    unsigned sum, cnt, mine, sp = 0u;
    for (;;) {
        sum = 0u; cnt = 0u; mine = 0u;
#pragma unroll
        for (unsigned j = 0; j < 16; ++j) { const unsigned c = xb_ld(&bar[XB_XCNT(j)]); sum += c; cnt += (c > 0u) ? 1u : 0u; mine = (j == x) ? c : mine; }
        if (sum == G) break;
        __builtin_amdgcn_s_sleep(1);
        if ((++sp & 255u) == 0u) { if (xb_ld(&bar[XB_TMO])) break; if (sp > XB_SPIN_CAP) { atomicAdd(&bar[XB_TMO], 1u); break; } }
    }
    nloc = mine > 0u ? mine : 1u; nx = cnt > 0u ? cnt : 1u;
}
DI void xcd_barrier(const XcdBarrier& b) {
    asm volatile("s_waitcnt vmcnt(0)" ::: "memory");
    __syncthreads();
    if (threadIdx.x == 0) {
        unsigned* bar = b.bar;
        __builtin_amdgcn_s_waitcnt(0);
        unsigned nloc = b.st[0], nx = b.st[1];
        if (nloc == 0u) { xcd_barrier_complete(bar, b.x, nloc, nx); b.st[0] = nloc; b.st[1] = nx; }
        const unsigned old = xb_add(&bar[XB_XSUB(b.x)], 1u);
        const unsigned gen = old / nloc;
        if (old + 1u == (gen + 1u) * nloc) {
            __builtin_amdgcn_fence(__ATOMIC_RELEASE, "agent");
            asm volatile("s_waitcnt vmcnt(0)" ::: "memory");
            const unsigned og = xb_add(&bar[XB_TOP], 1u);
            const unsigned tg = og / nx;
            if (og + 1u == (tg + 1u) * nx) xb_add(&bar[XB_TOPGEN], 1u);
            else XB_SPIN(xb_ld(&bar[XB_TOPGEN]) == tg, bar);
            __builtin_amdgcn_fence(__ATOMIC_ACQUIRE, "agent");
            xb_add(&bar[XB_XGEN(b.x)], 1u);
            asm volatile("s_waitcnt vmcnt(0)" ::: "memory");
        } else {
            XB_SPIN(xb_ld(&bar[XB_XGEN(b.x)]) == gen, bar);
            __builtin_amdgcn_fence(__ATOMIC_ACQUIRE, "agent");
            asm volatile("s_waitcnt vmcnt(0)" ::: "memory");
        }
    }
    __syncthreads();
}

DI void tr_item(const float* W, int K, int N, bf16_t* WT, int drow0, LAS float* scr, int k0, int n0, int lane, const float* gain = nullptr) {
#pragma unroll 8
    for (int i = 0; i < 32; ++i) { const int kk = 2 * i + (lane >> 5); scr[kk * 33 + (lane & 31)] = W[(size_t)(k0 + kk) * N + n0 + (lane & 31)]; }
    const int c = lane & 7;
    f32x4 g0 = {1.f, 1.f, 1.f, 1.f}, g1 = g0;
    if (gain) { g0 = *(const f32x4*)(gain + k0 + 8 * c); g1 = *(const f32x4*)(gain + k0 + 8 * c + 4); }
    LDS_WAIT(); asm volatile("" ::: "memory");
#pragma unroll
    for (int j = 0; j < 4; ++j) { const int n = (lane >> 3) + 8 * j; const LAS float* s = scr + (8 * c) * 33 + n;
        u32x4 o; o.x = pk2(s[0 * 33] * g0.x, s[1 * 33] * g0.y); o.y = pk2(s[2 * 33] * g0.z, s[3 * 33] * g0.w); o.z = pk2(s[4 * 33] * g1.x, s[5 * 33] * g1.y); o.w = pk2(s[6 * 33] * g1.z, s[7 * 33] * g1.w);
        *(u32x4*)(WT + (size_t)(drow0 + n) * K + k0 + 8 * c) = o; }
    LDS_WAIT(); asm volatile("" ::: "memory");
}
template <bool I8 = false> DI void tr_item8(const float* W, int K, int N, unsigned char* WT, int drow0, LAS float* scr, int k0, int n0, int lane, float scale, const float* gain = nullptr) {
#pragma unroll 8
    for (int i = 0; i < 64; ++i) { const int kk = 2 * i + (lane >> 5); scr[kk * 33 + (lane & 31)] = W[(size_t)(k0 + kk) * N + n0 + (lane & 31)] * scale; }
    LDS_WAIT(); asm volatile("" ::: "memory");
    const int c = lane & 7;
    f32x4 g0 = {1.f, 1.f, 1.f, 1.f}, g1 = g0, g2 = g0, g3 = g0;
    if (gain) { const float* gp = gain + k0 + 16 * c; g0 = *(const f32x4*)gp; g1 = *(const f32x4*)(gp + 4); g2 = *(const f32x4*)(gp + 8); g3 = *(const f32x4*)(gp + 12); }
#pragma unroll
    for (int j = 0; j < 4; ++j) { const int n = (lane >> 3) + 8 * j; const LAS float* s = scr + (16 * c) * 33 + n;
        u32x4 o;
        if (I8) { o.x = pk4_i8(s[0 * 33] * g0.x, s[1 * 33] * g0.y, s[2 * 33] * g0.z, s[3 * 33] * g0.w); o.y = pk4_i8(s[4 * 33] * g1.x, s[5 * 33] * g1.y, s[6 * 33] * g1.z, s[7 * 33] * g1.w);
                  o.z = pk4_i8(s[8 * 33] * g2.x, s[9 * 33] * g2.y, s[10 * 33] * g2.z, s[11 * 33] * g2.w); o.w = pk4_i8(s[12 * 33] * g3.x, s[13 * 33] * g3.y, s[14 * 33] * g3.z, s[15 * 33] * g3.w); }
        else { o.x = pk4_fp8(s[0 * 33] * g0.x, s[1 * 33] * g0.y, s[2 * 33] * g0.z, s[3 * 33] * g0.w); o.y = pk4_fp8(s[4 * 33] * g1.x, s[5 * 33] * g1.y, s[6 * 33] * g1.z, s[7 * 33] * g1.w);
               o.z = pk4_fp8(s[8 * 33] * g2.x, s[9 * 33] * g2.y, s[10 * 33] * g2.z, s[11 * 33] * g2.w); o.w = pk4_fp8(s[12 * 33] * g3.x, s[13 * 33] * g3.y, s[14 * 33] * g3.z, s[15 * 33] * g3.w); }
        *(u32x4*)(WT + (size_t)(drow0 + n) * K + k0 + 16 * c) = o; }
    LDS_WAIT(); asm volatile("" ::: "memory");
}
DI int vrow_inproj(int n) {
    if (n < 8192 || n >= 12288) return n;
    if (n < 10240) { const int j = n - 8192; return 8192 + (j >> 7) * 256 + (j & 127); }
    const int j = n - 10240; return 8192 + (j >> 7) * 256 + 128 + (j & 127);
}
DI int vrow_ffn(int n, int second) { return (n >> 7) * 256 + second * 128 + (n & 127); }

struct Args { const void* in[17]; float* out; unsigned char* ws; int ph_lo, ph_hi; };

DI void expert_convert_phase(const Args& a, LAS unsigned char* lds, int tid, int G) {
    unsigned char* ws = a.ws;
    const float* m1 = (const float*)a.in[14]; const float* m3 = (const float*)a.in[15]; const float* m2 = (const float*)a.in[16];
    __syncthreads();
    {
        constexpr int P = 257; LAS float* tile = (LAS float*)lds;
        const int w = tid >> 6, l = tid & 63, c = l & 7;
        f32x4 v[16];
        auto tile_src = [&](int t, int& N) -> const float* { const int e = t / 1056; int r = t - e * 1056; const int j = r / 352; r -= j * 352; const size_t eo = (size_t)e * 2048 * 5632;
            if (j < 2) { const int kb = r / 22, nb = r - kb * 22; N = 5632; return (j == 0 ? m1 : m3) + eo + (size_t)(128 * kb + 16 * w) * 5632 + 256 * nb + 4 * l; }
            const int kb = r / 8, nb = r - kb * 8; N = 2048; return m2 + eo + (size_t)(128 * kb + 16 * w) * 2048 + 256 * nb + 4 * l; };
        int t = (int)blockIdx.x;
        if (t < 8 * 1056) { int N; const float* sp = tile_src(t, N);
#pragma unroll
            for (int i = 0; i < 16; ++i) v[i] = *(const f32x4*)(sp + (size_t)i * N); }
        for (; t < 8 * 1056; t += G) {
            const int e = t / 1056; int r = t - e * 1056; const int j = r / 352; r -= j * 352;
            const float scale = j < 2 ? I8_SW : W8_SCALE;
#pragma unroll
            for (int i = 0; i < 16; ++i) { LAS float* d = tile + (16 * w + i) * P + 4 * l; d[0] = v[i].x * scale; d[1] = v[i].y * scale; d[2] = v[i].z * scale; d[3] = v[i].w * scale; }
            __syncthreads();
            if (t + G < 8 * 1056) { int N; const float* sp = tile_src(t + G, N);
#pragma unroll
                for (int i = 0; i < 16; ++i) v[i] = *(const f32x4*)(sp + (size_t)i * N); }
            unsigned char* WT; int K, k0, n0;
            if (j < 2) { const int kb = r / 22, nb = r - kb * 22; WT = ws + WS_MW13 + (size_t)e * 11264 * 2048; K = 2048; k0 = 128 * kb; n0 = 256 * nb; }
            else { const int kb = r / 8, nb = r - kb * 8; WT = ws + WS_MW2 + (size_t)e * 2048 * 5632; K = 5632; k0 = 128 * kb; n0 = 256 * nb; }
#pragma unroll
            for (int jj = 0; jj < 4; ++jj) { const int n = (tid >> 3) + 64 * jj; const LAS float* s = tile + (16 * c) * P + n;
                u32x4 o;
                if (j < 2) { o.x = pk4_i8(s[0 * P], s[1 * P], s[2 * P], s[3 * P]); o.y = pk4_i8(s[4 * P], s[5 * P], s[6 * P], s[7 * P]); o.z = pk4_i8(s[8 * P], s[9 * P], s[10 * P], s[11 * P]); o.w = pk4_i8(s[12 * P], s[13 * P], s[14 * P], s[15 * P]); }
                else { o.x = pk4_fp8(s[0 * P], s[1 * P], s[2 * P], s[3 * P]); o.y = pk4_fp8(s[4 * P], s[5 * P], s[6 * P], s[7 * P]); o.z = pk4_fp8(s[8 * P], s[9 * P], s[10 * P], s[11 * P]); o.w = pk4_fp8(s[12 * P], s[13 * P], s[14 * P], s[15 * P]); }
                const int drow = j < 2 ? vrow_ffn(n0 + n, j) : n0 + n;
                *(u32x4*)(WT + (size_t)drow * K + k0 + 16 * c) = o; }
            __syncthreads();
        }
    }
}
DI void prologue_phase(const Args& a, LAS unsigned char* lds, int gw, int NGW, int lane, int wave, int tid, int G) {
    unsigned char* ws = a.ws;
    LAS float* scr = (LAS float*)(lds + wave * 16896);
    const float* w_in = (const float*)a.in[5]; const float* w_ret = (const float*)a.in[7]; const float* w_conv = (const float*)a.in[8]; const float* w_out = (const float*)a.in[9];
    const float* f1 = (const float*)a.in[10]; const float* f3 = (const float*)a.in[11]; const float* f2 = (const float*)a.in[12];
    const float* m1 = (const float*)a.in[14]; const float* m3 = (const float*)a.in[15]; const float* m2 = (const float*)a.in[16];
    constexpr int I_G8 = 16 * 512, I_SQ = 32 * 64, I_SQ8 = 16 * 64, I_FF = 5632, I_FF8 = 2816;
    constexpr int NITEMS = 2 * I_G8 + 4 * I_SQ + 2 * I_SQ8 + 2 * I_FF8 + I_FF;
    for (int it = gw; it < NITEMS; it += NGW) {
        int r = it;
        if (r < 2 * I_G8) { const int l = r / I_G8; r -= l * I_G8; const int kb = r / 512, nb = r % 512;
            tr_item8<true>(w_in + (size_t)l * 2048 * 16384, 2048, 16384, ws + WS_WIN8 + (size_t)l * 16384 * 2048, vrow_inproj(32 * nb), scr, 128 * kb, 32 * nb, lane, I8_SW, (const float*)a.in[2] + l * 2048); continue; }
        r -= 2 * I_G8;
        if (r < 4 * I_SQ) { const int which = r / I_SQ; r -= which * I_SQ; const int mat = which >> 1, l = which & 1, kb = r / 64, nb = r % 64;
            const float* src = (mat == 0 ? w_ret : w_conv) + (size_t)l * 2048 * 2048;
            bf16_t* dst = (bf16_t*)(ws + (mat == 0 ? WS_WRET : WS_WCONV)) + (size_t)l * 2048 * 2048;
            tr_item(src, 2048, 2048, dst, 32 * nb, scr, 64 * kb, 32 * nb, lane); continue; }
        r -= 4 * I_SQ;
        if (r < 2 * I_SQ8) { const int l = r / I_SQ8; r -= l * I_SQ8; const int kb = r / 64, nb = r % 64;
            tr_item8<true>(w_out + (size_t)l * 2048 * 2048, 2048, 2048, ws + WS_WOUT + (size_t)l * 2048 * 2048, 32 * nb, scr, 128 * kb, 32 * nb, lane, I8_SW); continue; }
        r -= 2 * I_SQ8;
        if (r < 2 * I_FF8) { const int j = r / I_FF8; r -= j * I_FF8; const int kb = r / 176, nb = r % 176;
            tr_item8<true>(j == 0 ? f1 : f3, 2048, 5632, ws + WS_W13, vrow_ffn(32 * nb, j), scr, 128 * kb, 32 * nb, lane, I8_SW, (const float*)a.in[3]); continue; }
        r -= 2 * I_FF8;
        if (r < I_FF) { const int kb = r / 64, nb = r % 64; tr_item(f2, 5632, 2048, (bf16_t*)(ws + WS_W2), 32 * nb, scr, 64 * kb, 32 * nb, lane); continue; }
        r -= I_FF;
    }
    const int* pos = (const int*)a.in[1]; float* tabc = (float*)(ws + WS_TABC); float* tabs = (float*)(ws + WS_TABS);
    for (int idx = (gw * 64 + lane); idx < M_TOK * 128; idx += NGW * 64) { const int m = idx >> 7, i = idx & 127;
        const float inv = exp2f(-(float)i * (13.287712379549449f / 128.0f)); const float ang = (float)pos[m] * inv;
        const double rev = (double)ang * 0.15915494309189535; const float fr = (float)(rev - rint(rev));
        tabc[idx] = __builtin_amdgcn_cosf(fr); tabs[idx] = __builtin_amdgcn_sinf(fr); }
}

DI void cast_rows_phase(const float* x, unsigned char* x8, ss_t* ss, int gw, int NGW, int lane) {
    for (int m = gw; m < M_TOK; m += NGW) {
        const f32x4* xr = (const f32x4*)(x + (size_t)m * 2048) + lane; f32x4 v[8]; float s = 0.f;
#pragma unroll
        for (int j = 0; j < 8; ++j) { v[j] = xr[64 * j]; s += (v[j].x * v[j].x + v[j].y * v[j].y) + (v[j].z * v[j].z + v[j].w * v[j].w); }
        s = wave_sum(s);
        { unsigned* o4 = (unsigned*)(x8 + (size_t)m * 2048) + lane;
#pragma unroll
          for (int j = 0; j < 8; ++j) o4[64 * j] = pk4_i8(v[j].x * I8_SX, v[j].y * I8_SX, v[j].z * I8_SX, v[j].w * I8_SX); }
        if (lane < 8) ss[(size_t)m * 8 + lane] = lane == 0 ? s : 0.0f;
    }
}
template <bool ROUTE>
DI void norm_phase(LAS unsigned char* lds, const bf16_t* hb, const ss_t* ssp, const float* gain, bf16_t* xn, const float* router, unsigned* ctl, unsigned char* ws, int gw, int NGW, int lane, int tid) {
    LAS float* Rl = (LAS float*)lds;
    if (ROUTE) { for (int idx = tid; idx < 2048 * 8; idx += 512) Rl[(idx & 7) * 2048 + (idx >> 3)] = router[idx]; __syncthreads(); }
    f32x4 gv[8];
#pragma unroll
    for (int j = 0; j < 8; ++j) gv[j] = *(const f32x4*)(gain + 4 * lane + 256 * j);
    for (int m = gw; m < M_TOK; m += NGW) {
        const u32x2* xr = (const u32x2*)(hb + (size_t)m * 2048) + lane;
        f32x4 v[8];
#pragma unroll
        for (int j = 0; j < 8; ++j) { const u32x2 w = xr[64 * j]; v[j] = (f32x4){bf_lo(w.x), bf_hi(w.x), bf_lo(w.y), bf_hi(w.y)}; }
        const float rstd = ss_rstd(ssp, m);
        if (!ROUTE) { u32x2* o8 = (u32x2*)(xn + (size_t)m * 2048) + lane;
#pragma unroll
            for (int j = 0; j < 8; ++j) { v[j] = v[j] * rstd * gv[j]; u32x2 w; w.x = pk2(v[j].x, v[j].y); w.y = pk2(v[j].z, v[j].w); o8[64 * j] = w; } }
        if (ROUTE) {
            unsigned q8[8];
#pragma unroll
            for (int j = 0; j < 8; ++j) { v[j] = v[j] * rstd * gv[j]; q8[j] = pk4_i8(v[j].x * I8_SX, v[j].y * I8_SX, v[j].z * I8_SX, v[j].w * I8_SX); }
            int e0 = 0, e1 = 0; float v0 = -3.0e38f, v1 = -3.0e38f;
#pragma unroll 1
            for (int e = 0; e < 8; ++e) { float p = 0.f;
#pragma unroll
                for (int j = 0; j < 8; ++j) { const f32x4 rv = *(const LAS f32x4*)(Rl + e * 2048 + 4 * lane + 256 * j); p += (v[j].x * rv.x + v[j].y * rv.y) + (v[j].z * rv.z + v[j].w * rv.w); }
                const float xl = wave_sum(p);
                if (xl > v0) { v1 = v0; e1 = e0; v0 = xl; e0 = e; } else if (xl > v1) { v1 = xl; e1 = e; } }
            unsigned p0 = 0u, p1 = 0u;
            if (lane == 0) {
                const float ex = __expf(v1 - v0); const float g0 = 1.0f / (1.0f + ex), g1 = ex / (1.0f + ex);
                p0 = __hip_atomic_fetch_add(ctl + CW_CNT + 64 * e0, 1u, __ATOMIC_RELAXED, __HIP_MEMORY_SCOPE_AGENT);
                p1 = __hip_atomic_fetch_add(ctl + CW_CNT + 64 * e1, 1u, __ATOMIC_RELAXED, __HIP_MEMORY_SCOPE_AGENT);
                ((int2*)(ws + WS_RT_E))[m] = make_int2(e0, e1); ((int2*)(ws + WS_RT_POS))[m] = make_int2((int)p0, (int)p1); ((float2*)(ws + WS_RT_G))[m] = make_float2(g0, g1);
            }
            p0 = __builtin_amdgcn_readfirstlane(p0); p1 = __builtin_amdgcn_readfirstlane(p1);
            unsigned* d0 = (unsigned*)(ws + WS_XGS + ((size_t)e0 * 16384 + p0) * 2048) + lane; unsigned* d1 = (unsigned*)(ws + WS_XGS + ((size_t)e1 * 16384 + p1) * 2048) + lane;
#pragma unroll
            for (int j = 0; j < 8; ++j) { d0[64 * j] = q8[j]; d1[64 * j] = q8[j]; }
        }
    }
}

struct MoeBases { int b0, b1, b2, b3, b4, b5, b6, b7, b8; int c0, c1, c2, c3, c4, c5, c6, c7; };
DI MoeBases moe_bases(unsigned* ctl) {
    MoeBases B; int c[8];
#pragma unroll
    for (int e = 0; e < 8; ++e) c[e] = (int)__builtin_amdgcn_readfirstlane(__hip_atomic_load(ctl + CW_CNT + 64 * e, __ATOMIC_RELAXED, __HIP_MEMORY_SCOPE_AGENT));
    B.c0 = c[0]; B.c1 = c[1]; B.c2 = c[2]; B.c3 = c[3]; B.c4 = c[4]; B.c5 = c[5]; B.c6 = c[6]; B.c7 = c[7];
    B.b0 = 0; B.b1 = B.b0 + ((c[0] + 255) & ~255); B.b2 = B.b1 + ((c[1] + 255) & ~255); B.b3 = B.b2 + ((c[2] + 255) & ~255); B.b4 = B.b3 + ((c[3] + 255) & ~255);
    B.b5 = B.b4 + ((c[4] + 255) & ~255); B.b6 = B.b5 + ((c[5] + 255) & ~255); B.b7 = B.b6 + ((c[6] + 255) & ~255); B.b8 = B.b7 + ((c[7] + 255) & ~255);
    return B;
}
DI int moe_base_of(const MoeBases& B, int e) { return e == 0 ? B.b0 : e == 1 ? B.b1 : e == 2 ? B.b2 : e == 3 ? B.b3 : e == 4 ? B.b4 : e == 5 ? B.b5 : e == 6 ? B.b6 : B.b7; }

template <bool MOE, bool LAST>
DI void post_phase(const bf16_t* hb, float* outp, const float* gain, bf16_t* xn, unsigned char* ws, int gw, int NGW, int lane, const unsigned* donep = nullptr) {
    f32x4 gv[8];
#pragma unroll
    for (int j = 0; j < 8; ++j) gv[j] = *(const f32x4*)(gain + 4 * lane + 256 * j);
    const bf16_t* ym = (const bf16_t*)(ws + WS_XG);
    const MoeBases MB = moe_bases((unsigned*)(ws + WS_CTL));
    unsigned todo = 0u; { int idx = 0; for (int m = gw; m < M_TOK; m += NGW, ++idx) todo |= 1u << idx; }
    for (int pass = 0; pass < 2 && todo != 0u; ++pass) {
    unsigned ready = todo;
    if (MOE && donep) {
        ready = 0u; int idx = 0;
        for (int m = gw; m < M_TOK; m += NGW, ++idx) { if (!((todo >> idx) & 1u)) continue;
            const int2 ee = ((const int2*)(ws + WS_RT_E))[m]; const int2 pp = ((const int2*)(ws + WS_RT_POS))[m];
            const unsigned* c0 = donep + 16 * (__builtin_amdgcn_readfirstlane(moe_base_of(MB, ee.x) + pp.x) >> 8); const unsigned* c1 = donep + 16 * (__builtin_amdgcn_readfirstlane(moe_base_of(MB, ee.y) + pp.y) >> 8);
            bool ok = (unsigned)__builtin_amdgcn_readfirstlane(__hip_atomic_load(c0, __ATOMIC_RELAXED, __HIP_MEMORY_SCOPE_AGENT)) >= DONE_NEED && (unsigned)__builtin_amdgcn_readfirstlane(__hip_atomic_load(c1, __ATOMIC_RELAXED, __HIP_MEMORY_SCOPE_AGENT)) >= DONE_NEED;
            if (pass == 1) for (unsigned sp = 0; sp < (1u << 20) && !ok; ++sp) { __builtin_amdgcn_s_sleep(4);
                ok = (unsigned)__builtin_amdgcn_readfirstlane(__hip_atomic_load(c0, __ATOMIC_RELAXED, __HIP_MEMORY_SCOPE_AGENT)) >= DONE_NEED && (unsigned)__builtin_amdgcn_readfirstlane(__hip_atomic_load(c1, __ATOMIC_RELAXED, __HIP_MEMORY_SCOPE_AGENT)) >= DONE_NEED; }
            if (ok || pass == 1) ready |= 1u << idx; }
        if (ready != 0u) { __builtin_amdgcn_fence(__ATOMIC_ACQUIRE, "agent"); asm volatile("s_waitcnt vmcnt(0)" ::: "memory"); }
    }
    todo &= ~ready;
    int idx = 0;
    for (int m = gw; m < M_TOK; m += NGW, ++idx) {
        if (!((ready >> idx) & 1u)) continue;
        int2 r = make_int2(0, 0);
        if (MOE) { const int2 ee = ((const int2*)(ws + WS_RT_E))[m]; const int2 pp = ((const int2*)(ws + WS_RT_POS))[m]; r = make_int2(moe_base_of(MB, ee.x) + pp.x, moe_base_of(MB, ee.y) + pp.y); }
        const u32x2* hr = (const u32x2*)(hb + (size_t)m * 2048) + lane;
        f32x4* xr = (f32x4*)(outp + (size_t)m * 2048) + lane;
        f32x4 v[8]; float s = 0.f;
#pragma unroll
        for (int j = 0; j < 8; ++j) { const u32x2 w = hr[64 * j]; v[j] = (f32x4){bf_lo(w.x), bf_hi(w.x), bf_lo(w.y), bf_hi(w.y)}; }
        if (MOE) { const float2 g = ((const float2*)(ws + WS_RT_G))[m];
            const u32x2* y0 = (const u32x2*)(ym + (size_t)r.x * 2048) + lane; const u32x2* y1 = (const u32x2*)(ym + (size_t)r.y * 2048) + lane;
#pragma unroll
            for (int j = 0; j < 8; ++j) { const u32x2 a = y0[64 * j], b = y1[64 * j];
                v[j].x += g.x * bf_lo(a.x) + g.y * bf_lo(b.x); v[j].y += g.x * bf_hi(a.x) + g.y * bf_hi(b.x); v[j].z += g.x * bf_lo(a.y) + g.y * bf_lo(b.y); v[j].w += g.x * bf_hi(a.y) + g.y * bf_hi(b.y); } }
#pragma unroll
        for (int j = 0; j < 8; ++j) s += (v[j].x * v[j].x + v[j].y * v[j].y) + (v[j].z * v[j].z + v[j].w * v[j].w);
        const float rstd = 1.0f / sqrtf(wave_sum(s) * (1.0f / 2048.0f) + EPS);
        if (LAST) {
#pragma unroll
            for (int j = 0; j < 8; ++j) xr[64 * j] = v[j] * rstd * gv[j];
        } else {
            if (MOE) {
#pragma unroll
                for (int j = 0; j < 8; ++j) xr[64 * j] = v[j];
            }
            u32x2* o8 = (u32x2*)(xn + (size_t)m * 2048) + lane;
#pragma unroll
            for (int j = 0; j < 8; ++j) { const f32x4 y = v[j] * rstd * gv[j]; u32x2 w; w.x = pk2(y.x, y.y); w.y = pk2(y.z, y.w); o8[64 * j] = w; }
        }
    }
    }
}

DI void finalize_conv_phase(unsigned char* ws, const float* convw, int gw, int NGW, int lane, int G, int tid) {
    const bf16_t* O = (const bf16_t*)(ws + WS_ORAW); bf16_t* SG = (bf16_t*)(ws + WS_SG);
    for (int m = gw; m < M_TOK; m += NGW) {
#pragma unroll
        for (int hh = 0; hh < 4; ++hh) { const size_t off = (size_t)m * 2048 + hh * 512 + lane * 8;
            f32x4 a, b, ga, gb; pg8::unpack8(*(const u32x4*)(O + off), a, b); pg8::unpack8(*(const u32x4*)(SG + off), ga, gb);
            const float mean = wave_sum((a.x + a.y) + (a.z + a.w) + (b.x + b.y) + (b.z + b.w)) * (1.0f / 512.0f);
            a = a - mean; b = b - mean;
            const float var = wave_sum((a.x * a.x + a.y * a.y) + (a.z * a.z + a.w * a.w) + (b.x * b.x + b.y * b.y) + (b.z * b.z + b.w * b.w)) * (1.0f / 512.0f);
            const float rstd = 1.0f / sqrtf(var + EPS);
            *(u32x4*)(SG + off) = pg8::pack8(a * rstd * ga, b * rstd * gb); }
    }
    const bf16_t* U = (const bf16_t*)(ws + WS_U); bf16_t* CB = (bf16_t*)(ws + WS_CB);
    const int nthr = G * 512, gtid = blockIdx.x * 512 + tid;
    for (int it = gtid; it < (M_TOK / 16) * 256; it += nthr) { const int cg = it & 255, rb = it >> 8, m0 = rb * 16, c0 = cg * 8;
        f32x4 w0a = *(const f32x4*)(convw + c0), w0b = *(const f32x4*)(convw + c0 + 4), w1a = *(const f32x4*)(convw + 2048 + c0), w1b = *(const f32x4*)(convw + 2048 + c0 + 4),
              w2a = *(const f32x4*)(convw + 4096 + c0), w2b = *(const f32x4*)(convw + 4096 + c0 + 4);
        f32x4 p2a = {0.f, 0.f, 0.f, 0.f}, p2b = p2a, p1a = p2a, p1b = p2a;
        if ((m0 & (T_SEQ - 1)) != 0) { pg8::unpack8(*(const u32x4*)(U + (size_t)(m0 - 2) * 2048 + c0), p2a, p2b); pg8::unpack8(*(const u32x4*)(U + (size_t)(m0 - 1) * 2048 + c0), p1a, p1b); }
#pragma unroll 4
        for (int r = 0; r < 16; ++r) { const size_t off = (size_t)(m0 + r) * 2048 + c0; f32x4 ua, ub, ca, cb;
            pg8::unpack8(*(const u32x4*)(U + off), ua, ub); pg8::unpack8(*(const u32x4*)(CB + off), ca, cb);
            const f32x4 ya = w0a * p2a + w1a * p1a + w2a * ua, yb = w0b * p2b + w1b * p1b + w2b * ub;
            *(u32x4*)(CB + off) = pg8::pack8(ca * ya, cb * yb);
            p2a = p1a; p2b = p1b; p1a = ua; p1b = ub; }
    }
}

DI bf16x8 tr_frag(const LAS unsigned char* p0, const LAS unsigned char* p1) {
    const s16x4 lo = __builtin_amdgcn_ds_read_tr16_b64_v4i16((LAS s16x4*)p0), hi = __builtin_amdgcn_ds_read_tr16_b64_v4i16((LAS s16x4*)p1);
    return __builtin_shufflevector(lo, hi, 0, 1, 2, 3, 4, 5, 6, 7);
}
DI void retention_phase(LAS unsigned char* lds, unsigned char* ws, int G) {
    int tid_ = threadIdx.x; asm volatile("" : "+v"(tid_));
    const int tid = tid_, lane = tid & 63, w = __builtin_amdgcn_readfirstlane(tid >> 6), l15 = lane & 15, g = lane >> 4, q = l15 >> 2, p = l15 & 3;
    constexpr int PK = 528, PV = 144, PS = 528;
    LAS unsigned char* KS = lds; LAS unsigned char* VS = lds + 128 * PK; LAS unsigned char* STT = VS + 128 * PV;
    const bf16_t* Qg = (const bf16_t*)(ws + WS_Q); const bf16_t* Kg = (const bf16_t*)(ws + WS_K); const bf16_t* Vg = (const bf16_t*)(ws + WS_V); bf16_t* Og = (bf16_t*)(ws + WS_ORAW);
    for (int unit = blockIdx.x; unit < 256; unit += G) {
        const int b = unit >> 5, hh = (unit >> 3) & 3, sl = unit & 7;
        const float g128 = __builtin_amdgcn_exp2f(128.0f * log2gamma(hh));
        const size_t r0 = (size_t)b * T_SEQ;
        const bf16_t* Qb = Qg + r0 * 1024 + hh * 256; const bf16_t* Kb = Kg + r0 * 1024 + hh * 256; const bf16_t* Vb = Vg + r0 * 2048 + hh * 512 + sl * 64; bf16_t* Ob = Og + r0 * 2048 + hh * 512 + sl * 64;
        f32x4 stt[4][2];
#pragma unroll
        for (int mt = 0; mt < 4; ++mt) { stt[mt][0] = (f32x4){0.f, 0.f, 0.f, 0.f}; stt[mt][1] = (f32x4){0.f, 0.f, 0.f, 0.f}; }
        u32x4 kpre[8], vpre[2];
#pragma unroll
        for (int it = 0; it < 8; ++it) { const int idx = it * 512 + tid; kpre[it] = *(const u32x4*)(Kb + (size_t)(idx >> 5) * 1024 + (idx & 31) * 8); }
#pragma unroll
        for (int it = 0; it < 2; ++it) { const int idx = it * 512 + tid; vpre[it] = *(const u32x4*)(Vb + (size_t)(idx >> 3) * 2048 + (idx & 7) * 8); }
        for (int c = 0; c < 16; ++c) {
#pragma unroll
            for (int it = 0; it < 8; ++it) { const int idx = it * 512 + tid; *(LAS u32x4*)(KS + (idx >> 5) * PK + (idx & 31) * 16) = kpre[it]; }
#pragma unroll
            for (int it = 0; it < 2; ++it) { const int idx = it * 512 + tid; *(LAS u32x4*)(VS + (idx >> 3) * PV + (idx & 7) * 16) = vpre[it]; }
#pragma unroll
            for (int mt = 0; mt < 4; ++mt)
#pragma unroll
                for (int nt = 0; nt < 2; ++nt)
#pragma unroll
                    for (int r = 0; r < 4; ++r) *(LAS bf16_t*)(STT + (16 * mt + 4 * g + r) * PS + (32 * w + 16 * nt + l15) * 2) = f2bf(stt[mt][nt][r]);
            bf16x8 qf[8];
            { const bf16_t* qp = Qb + (size_t)(128 * c + 16 * w + l15) * 1024 + 8 * g;
#pragma unroll
              for (int s = 0; s < 8; ++s) qf[s] = *(const bf16x8*)(qp + 32 * s); }
            __syncthreads();
            if (c + 1 < 16) {
#pragma unroll
                for (int it = 0; it < 8; ++it) { const int idx = it * 512 + tid; kpre[it] = *(const u32x4*)(Kb + (size_t)(128 * (c + 1) + (idx >> 5)) * 1024 + (idx & 31) * 8); }
#pragma unroll
                for (int it = 0; it < 2; ++it) { const int idx = it * 512 + tid; vpre[it] = *(const u32x4*)(Vb + (size_t)(128 * (c + 1) + (idx >> 3)) * 2048 + (idx & 7) * 8); }
            }
            f32x4 oacc[4];
#pragma unroll
            for (int nt = 0; nt < 4; ++nt) oacc[nt] = (f32x4){0.f, 0.f, 0.f, 0.f};
            const int npairs = (w >> 1) + 1, iq = 16 * w + l15;
            for (int pp = 0; pp < npairs; ++pp) {
                const int ja = 2 * pp, jb = ja + 1;
                f32x4 sa = {0.f, 0.f, 0.f, 0.f}, sb = {0.f, 0.f, 0.f, 0.f};
                const LAS unsigned char* ka = KS + (16 * ja + l15) * PK + 16 * g; const LAS unsigned char* kb = ka + 16 * PK;
#pragma unroll
                for (int s = 0; s < 8; ++s) { const bf16x8 fa = *(const LAS bf16x8*)(ka + 64 * s), fb = *(const LAS bf16x8*)(kb + 64 * s);
                    sa = __builtin_amdgcn_mfma_f32_16x16x32_bf16(fa, qf[s], sa, 0, 0, 0); sb = __builtin_amdgcn_mfma_f32_16x16x32_bf16(fb, qf[s], sb, 0, 0, 0); }
#pragma unroll
                for (int e = 0; e < 4; ++e) { sa[e] = (16 * ja + 4 * g + e <= iq) ? sa[e] : 0.f; sb[e] = (16 * jb + 4 * g + e <= iq) ? sb[e] : 0.f; }
                u32x4 pw; pw.x = pk2(sa[0], sa[1]); pw.y = pk2(sa[2], sa[3]); pw.z = pk2(sb[0], sb[1]); pw.w = pk2(sb[2], sb[3]);
                const bf16x8 pf = __builtin_bit_cast(bf16x8, pw);
                const LAS unsigned char* va = VS + (16 * ja + 4 * g + q) * PV + 8 * p; const LAS unsigned char* vb = va + 16 * PV;
#pragma unroll
                for (int nt = 0; nt < 4; ++nt) { const bf16x8 vf = tr_frag(va + 32 * nt, vb + 32 * nt); oacc[nt] = __builtin_amdgcn_mfma_f32_16x16x32_bf16(vf, pf, oacc[nt], 0, 0, 0); }
            }
            { const LAS unsigned char* sp = STT + l15 * PS + 16 * g;
#pragma unroll
              for (int s = 0; s < 8; ++s)
#pragma unroll
                  for (int nt = 0; nt < 4; ++nt) { const bf16x8 sf = *(const LAS bf16x8*)(sp + 16 * nt * PS + 64 * s); oacc[nt] = __builtin_amdgcn_mfma_f32_16x16x32_bf16(sf, qf[s], oacc[nt], 0, 0, 0); } }
            { bf16_t* op = Ob + (size_t)(128 * c + 16 * w + l15) * 2048 + 4 * g;
#pragma unroll
              for (int nt = 0; nt < 4; ++nt) { u32x2 o2; o2.x = pk2(oacc[nt][0], oacc[nt][1]); o2.y = pk2(oacc[nt][2], oacc[nt][3]); *(u32x2*)(op + 16 * nt) = o2; } }
#pragma unroll
            for (int s = 0; s < 4; ++s) {
                const LAS unsigned char* vp = VS + (32 * s + 8 * g + q) * PV + 8 * p; const LAS unsigned char* kp = KS + (32 * s + 8 * g + q) * PK + (32 * w) * 2 + 8 * p;
                bf16x8 af[4], bfv[2];
#pragma unroll
                for (int mt = 0; mt < 4; ++mt) af[mt] = tr_frag(vp + 32 * mt, vp + 4 * PV + 32 * mt);
#pragma unroll
                for (int nt = 0; nt < 2; ++nt) bfv[nt] = tr_frag(kp + 32 * nt, kp + 4 * PK + 32 * nt);
#pragma unroll
                for (int mt = 0; mt < 4; ++mt)
#pragma unroll
                    for (int nt = 0; nt < 2; ++nt) stt[mt][nt] = __builtin_amdgcn_mfma_f32_16x16x32_bf16(af[mt], bfv[nt], stt[mt][nt], 0, 0, 0);
            }
#pragma unroll
            for (int mt = 0; mt < 4; ++mt) { stt[mt][0] = stt[mt][0] * g128; stt[mt][1] = stt[mt][1] * g128; }
            __syncthreads();
        }
    }
}

constexpr int NPHASE = 21;

struct Ctx { unsigned char* ws; unsigned* ctl; float* out; int lo, hi; };
#define IN(k) (C.lo <= (k) && (k) < C.hi)
#define SEAM(k) do { if (IN(k) && IN((k) + 1)) xcd_barrier(bar); } while (0)
#define PHASE_COORDS() int tid = threadIdx.x; asm volatile("" : "+v"(tid)); const int lane = tid & 63, wave = __builtin_amdgcn_readfirstlane(tid >> 6); \
    const int G = gridDim.x; const int vcu = (G % 8 == 0) ? ((int)blockIdx.x % 8) * (G / 8) + (int)blockIdx.x / 8 : (int)blockIdx.x; const int gw = vcu * 8 + wave, NGW = G * 8; (void)lane; (void)gw; (void)NGW

template <int L>
DI void layer_phases(const Args& a, const Ctx& C, LAS unsigned char* lds, const XcdBarrier& bar) {
    constexpr int pb = 1 + 10 * L;
    unsigned char* ws = C.ws;
    ss_t* ssb = (ss_t*)(ws + WS_SS);
    LAS float* red = (LAS float*)(lds + MISC_OFF + 1024);
    bf16_t* HB = (bf16_t*)(ws + WS_HB);
    if (IN(pb + 0)) {
        const int G = gridDim.x;
        pg8::Gemm g{L == 0 ? (const void*)(ws + WS_X8) : (const void*)(ws + WS_HB8), ws + WS_WIN8 + (size_t)L * 16384 * 2048, 2048}; pg8::StaticOrder S; S.init(64, 64, G, (int)blockIdx.x);
        pg8::EpiInProj E{(bf16_t*)(ws + WS_Q), (bf16_t*)(ws + WS_K), (bf16_t*)(ws + WS_V), (bf16_t*)(ws + WS_SG), (bf16_t*)(ws + WS_CB), (bf16_t*)(ws + WS_U), (bf16_t*)(ws + WS_SGA), (bf16_t*)(ws + WS_SGB),
                         (const float*)(ws + WS_TABC), (const float*)(ws + WS_TABS), ssb + (size_t)(L == 0 ? 0 : 2) * M_TOK * 8, 1.0f / ((L == 0 ? I8_SX : I8_SH) * I8_SW)};
        pg8::gemm_phase<2>(lds, g, S, E);
    }
    SEAM(pb + 0);
    if (IN(pb + 1)) retention_phase(lds, ws, (int)gridDim.x);
    SEAM(pb + 1);
    if (IN(pb + 2)) { PHASE_COORDS(); finalize_conv_phase(ws, (const float*)a.in[6] + (size_t)L * 3 * 2048, gw, NGW, lane, G, tid); }
    SEAM(pb + 2);
    if (IN(pb + 3)) {
        const int G = gridDim.x; pg8::PairOrder S{G, (int)blockIdx.x, 8 * L};
        pg8::Gemm g{(const bf16_t*)(ws + WS_SG), (const bf16_t*)(ws + WS_WRET), 4096}; pg8::EpiGatePair E{ws + WS_SGA, ws + WS_SGB, ws + WS_M8}; pg8::gemm_phase(lds, g, S, E);
    }
    SEAM(pb + 3);
    if (IN(pb + 4)) {
        const int G = gridDim.x;
        pg8::Gemm g{ws + WS_M8, ws + WS_WOUT + (size_t)L * 2048 * 2048, 2048}; pg8::StaticOrder S; S.init(64, 8, G, (int)blockIdx.x); constexpr float osc = 1.0f / (I8_SG * I8_SW);
        if (L == 0) { pg8::EpiResidB<true> E{a.in[0], HB, ssb + (size_t)1 * M_TOK * 8, red, ws + WS_X8, I8_SM, osc};     pg8::gemm_phase<2>(lds, g, S, E); }
        else { pg8::EpiResidB<false> E{HB, HB, ssb + (size_t)3 * M_TOK * 8, red, nullptr, 0.f, osc}; pg8::gemm_phase<2>(lds, g, S, E); }
    }
    SEAM(pb + 4);
    if (L == 1) {
        if (IN(pb + 5)) { PHASE_COORDS(); norm_phase<true>(lds, HB, ssb + (size_t)3 * M_TOK * 8, (const float*)a.in[3] + 2048, (bf16_t*)(ws + WS_XN), (const float*)a.in[13], C.ctl, ws, gw, NGW, lane, tid); __syncthreads(); expert_convert_phase(a, lds, tid, G);
            { LAS unsigned* MISC = (LAS unsigned*)(lds + MISC_OFF); __syncthreads(); for (int u = tid; u < (LDS_BYTES - MISC_OFF) / 4; u += 512) MISC[u] = 0u; __syncthreads(); } }
        SEAM(pb + 5);
    }
    if (IN(pb + 7)) {
        const int G = gridDim.x;
        if (L == 0) { pg8::Gemm g{ws + WS_X8, ws + WS_W13, 2048}; pg8::StaticOrder S; S.init(64, 44, G, (int)blockIdx.x); pg8::EpiSwiglu E{(bf16_t*)(ws + WS_ACT), ssb + (size_t)1 * M_TOK * 8, 1.0f / (I8_SM * I8_SW)}; pg8::gemm_phase<2>(lds, g, S, E); }
        else { const MoeBases B = moe_bases(C.ctl); pg8::MoeOrder S{44, G, (int)blockIdx.x, B.b1 >> 8, B.b2 >> 8, B.b3 >> 8, B.b4 >> 8, B.b5 >> 8, B.b6 >> 8, B.b7 >> 8, B.b8 >> 8, 1, nullptr};
               pg8::Gemm g{ws + WS_XGS, ws + WS_MW13, 2048}; pg8::EpiSwiglu8 E{ws + WS_ACT, 1.0f / (I8_SX * I8_SW)}; pg8::gemm_phase<2>(lds, g, S, E); }
    }
    SEAM(pb + 7);
    if (IN(pb + 8)) {
        const int G = gridDim.x;
        if (L == 0) { pg8::Gemm g{(const bf16_t*)(ws + WS_ACT), (const bf16_t*)(ws + WS_W2), 11264}; pg8::StaticOrder S; S.init(64, 8, G, (int)blockIdx.x); pg8::EpiResidB<false> E{HB, HB, ssb + (size_t)2 * M_TOK * 8, red, ws + WS_HB8, I8_SH, 1.0f}; pg8::gemm_phase(lds, g, S, E); }
        else { const MoeBases B = moe_bases(C.ctl); pg8::MoeOrder S{8, G, (int)blockIdx.x, B.b1 >> 8, B.b2 >> 8, B.b3 >> 8, B.b4 >> 8, B.b5 >> 8, B.b6 >> 8, B.b7 >> 8, B.b8 >> 8, 0, C.ctl + CW_DONE};
               pg8::Gemm g{ws + WS_ACT, ws + WS_MW2, 5632}; pg8::EpiBf16PlainWT E{(bf16_t*)(ws + WS_XG), 1.0f / W8_SCALE}; pg8::gemm_phase<1>(lds, g, S, E); }
    }
    if (L == 0) SEAM(pb + 8);
    if (L == 1) { if (IN(pb + 9)) { PHASE_COORDS(); post_phase<true, true>(HB, C.out, (const float*)a.in[4], nullptr, ws, gw, NGW, lane, C.ctl + CW_DONE); } }
}

__global__ void __launch_bounds__(512, 2) mk_fwd(Args a) {
    extern __shared__ __attribute__((aligned(16))) unsigned char lds_raw[];
    LAS unsigned char* lds = (LAS unsigned char*)lds_raw;
    Ctx C; C.ws = a.ws; C.ctl = (unsigned*)(a.ws + WS_CTL); C.out = a.out; C.lo = a.ph_lo; C.hi = a.ph_hi;
    volatile LAS unsigned* MISC = (volatile LAS unsigned*)(lds + MISC_OFF);
    for (int u = threadIdx.x; u < (LDS_BYTES - MISC_OFF) / 4; u += 512) MISC[u] = 0u;
    __syncthreads();
    XcdBarrier bar; bar.bar = C.ctl + CW_BAR; bar.x = 0; bar.st = nullptr;
    if (C.hi - C.lo > 1) bar = xcd_barrier_post(C.ctl + CW_BAR, MISC + 8);
    if (IN(0)) { PHASE_COORDS(); prologue_phase(a, lds, gw, NGW, lane, wave, tid, G);
        __syncthreads(); for (int u = tid; u < (LDS_BYTES - MISC_OFF) / 4; u += 512) MISC[u] = 0u; __syncthreads();
        cast_rows_phase((const float*)a.in[0], C.ws + WS_X8, (ss_t*)(C.ws + WS_SS), gw, NGW, lane); }
    SEAM(0);
    layer_phases<0>(a, C, lds, bar);
    layer_phases<1>(a, C, lds, bar);
}
#undef IN
#undef SEAM

extern "C" void kernel_launch(void* const* d_in, const int* in_sizes, int n_in, void* d_out, int out_size, void* d_ws, size_t ws_size, hipStream_t stream) {
    static int grid = 0;
    if (grid == 0) {
        if (n_in != 17 || out_size != M_TOK * D_MODEL || ws_size < WS_END) { fprintf(stderr, "kernel_launch: unexpected problem (n_in %d, out %d, ws %zu)\n", n_in, out_size, ws_size); grid = -1; return; }
        int dev = 0, cus = 0, per_cu = 0;
        if (hipGetDevice(&dev) != hipSuccess || hipDeviceGetAttribute(&cus, hipDeviceAttributeMultiprocessorCount, dev) != hipSuccess) { grid = -1; return; }
        if (hipFuncSetAttribute((const void*)mk_fwd, hipFuncAttributeMaxDynamicSharedMemorySize, LDS_BYTES) != hipSuccess) { fprintf(stderr, "kernel_launch: hipFuncSetAttribute failed\n"); grid = -1; return; }
        if (hipOccupancyMaxActiveBlocksPerMultiprocessor(&per_cu, (const void*)mk_fwd, 512, LDS_BYTES) != hipSuccess || per_cu < 1) { fprintf(stderr, "kernel_launch: occupancy query says %d\n", per_cu); (void)hipGetLastError(); grid = -1; return; }
        grid = cus;
    }
    if (grid < 0) return;
    (void)hipMemsetAsync((char*)d_ws + WS_CTL, 0, CTL_ZERO_BYTES, stream);
    Args a{};
    for (int i = 0; i < 17; ++i) a.in[i] = d_in[i];
    a.out = (float*)d_out; a.ws = (unsigned char*)d_ws;
#if MK_ONE_LAUNCH
    a.ph_lo = 0; a.ph_hi = NPHASE;
    hipLaunchKernelGGL(mk_fwd, dim3(grid), dim3(512), LDS_BYTES, stream, a);
#else
    for (int k = 0; k < NPHASE; ++k) { if (k == 1 + 6) continue;
        a.ph_lo = k; a.ph_hi = k + 1; hipLaunchKernelGGL(mk_fwd, dim3(grid), dim3(512), LDS_BYTES, stream, a); }
#endif
}
```

```cpp
#include <hip/hip_runtime.h>
#include <stdio.h>

#ifndef MK_ONE_LAUNCH
#define MK_ONE_LAUNCH 1
#endif

#define LAS __attribute__((address_space(3)))
#define GAS __attribute__((address_space(1)))
typedef unsigned short bf16_t;
typedef short bf16x8 __attribute__((ext_vector_type(8)));
typedef short s16x4 __attribute__((ext_vector_type(4)));
typedef float f32x4 __attribute__((ext_vector_type(4)));
typedef float f32x2 __attribute__((ext_vector_type(2)));
typedef unsigned u32x4 __attribute__((ext_vector_type(4)));
typedef unsigned u32x2 __attribute__((ext_vector_type(2)));
typedef __bf16 bf2_t __attribute__((ext_vector_type(2)));
typedef int i32x8 __attribute__((ext_vector_type(8)));
typedef int i32x4 __attribute__((ext_vector_type(4)));
#define DI __device__ __forceinline__

constexpr int M_TOK = 16384, T_SEQ = 2048, D_MODEL = 2048, D_IN = 16384, D_FF = 5632, N_EXP = 8;
constexpr int MOE_MAX_ROWS = 34816;
constexpr float EPS = 1e-6f;

DI unsigned pk2(float lo, float hi) { f32x2 v = {lo, hi}; bf2_t r = __builtin_convertvector(v, bf2_t); return __builtin_bit_cast(unsigned, r); }
DI bf16_t f2bf(float f) { return (bf16_t)(pk2(f, 0.f) & 0xffffu); }
DI unsigned pk4_fp8(float a, float b, float c, float d) { int p = __builtin_amdgcn_cvt_pk_fp8_f32(a, b, 0, false); p = __builtin_amdgcn_cvt_pk_fp8_f32(c, d, p, true); return (unsigned)p; }
DI unsigned pk4_i8(float a, float b, float c, float d) {
    int qa = (int)__builtin_rintf(a), qb = (int)__builtin_rintf(b), qc = (int)__builtin_rintf(c), qd = (int)__builtin_rintf(d);
    qa = qa < -127 ? -127 : (qa > 127 ? 127 : qa); qb = qb < -127 ? -127 : (qb > 127 ? 127 : qb); qc = qc < -127 ? -127 : (qc > 127 ? 127 : qc); qd = qd < -127 ? -127 : (qd > 127 ? 127 : qd);
    return (unsigned)(qa & 255) | ((unsigned)(qb & 255) << 8) | ((unsigned)(qc & 255) << 16) | ((unsigned)qd << 24);
}
constexpr float I8_SX = 32.0f, I8_SM = 28.0f, I8_SH = 24.0f, I8_SG = 32.0f, I8_SW = 1408.0f;
DI unsigned pk4_u8(float a, float b, float c, float d) {
    return (unsigned)fmaxf(a * 255.0f + 0.5f, 1.0f) | ((unsigned)fmaxf(b * 255.0f + 0.5f, 1.0f) << 8) | ((unsigned)fmaxf(c * 255.0f + 0.5f, 1.0f) << 16) | ((unsigned)fmaxf(d * 255.0f + 0.5f, 1.0f) << 24);
}
DI f32x4 u8x4_f(unsigned w) { return (f32x4){(float)(w & 255u), (float)((w >> 8) & 255u), (float)((w >> 16) & 255u), (float)(w >> 24)} * (1.0f / 255.0f); }
DI float bf_lo(unsigned w) { return __builtin_bit_cast(float, w << 16); }
DI float bf_hi(unsigned w) { return __builtin_bit_cast(float, w & 0xffff0000u); }
DI float fsigmoid(float x) { return __builtin_amdgcn_rcpf(1.0f + __builtin_amdgcn_exp2f(-1.4426950408889634f * x)); }
DI float fsilu(float x) { return x * fsigmoid(x); }
DI float wave_sum(float v) {
#pragma unroll
    for (int o = 1; o < 64; o <<= 1) v += __shfl_xor(v, o);
    return v;
}
typedef float ss_t;
DI float ss_rstd(const ss_t* ss, int row) { const f32x4 a = *(const f32x4*)(ss + (size_t)row * 8), b = *(const f32x4*)(ss + (size_t)row * 8 + 4); return __builtin_amdgcn_rsqf((((a.x + a.y) + (a.z + a.w)) + ((b.x + b.y) + (b.z + b.w))) * (1.0f / 2048.0f) + EPS); }
DI float log2gamma(int h) { return h == 0 ? -0.04580368961312479f : (h == 1 ? -0.02272007650008353f : (h == 2 ? -0.011315313227834146f : -0.005646563141142063f)); }
#define LDS_WAIT() asm volatile("s_waitcnt lgkmcnt(0)" ::: "memory")
#define VM_WAIT() asm volatile("s_waitcnt vmcnt(0)" ::: "memory")

namespace pg8 {
constexpr int BM = 256, BK = 64, HALF = 128, HTB = HALF * BK * 2, STAGE_BYTES = 8 * HTB, NXCD = 8, WGM = 8;
DI int lds_byte(int r, int c) { const int st = (r >> 4) * 2 + (c >> 5), rr = r & 15, cc = c & 31, ob = rr * 64 + cc * 2; return st * 1024 + (ob ^ (((ob >> 9) & 1) << 5)); }
DI void stage_rc(int b, int& R, int& C) { const int st = b / 1024, sb = b % 1024, swz = sb ^ (((sb >> 9) & 1) << 5); R = (st >> 1) * 16 + swz / 64; C = (st & 1) * 32 + (swz % 64) / 2; }
DI int perm32(int rho) { const int n = rho >> 4, i = rho & 15; return 8 * (i >> 2) + 4 * n + (i & 3); }

struct Unit { int pm, pn, pb, pa; };
struct Gemm { const void* A; const void* Bt; int Kb; };

DI void order_map(int L, int nM, int nN, int& pm, int& pn) {
    const int nwg = nM * nN;
    int wgid = L; { const int q = nwg / NXCD, r = nwg % NXCD, xcd = wgid % NXCD, off = wgid / NXCD; wgid = (xcd < r ? xcd * (q + 1) : r * (q + 1) + (xcd - r) * q) + off; }
    const int nig = WGM * nN, gid = wgid / nig, fm = gid * WGM, gsz = (nM - fm) < WGM ? (nM - fm) : WGM;
    pm = fm + ((wgid % nig) % gsz); pn = (wgid % nig) / gsz;
}
struct StaticOrder {
    int nM, nN, nwg, G, c;
    DI void init(int nM_, int nN_, int G_, int c_) { nM = nM_; nN = nN_; nwg = nM * nN; G = G_; c = c_; }
    DI bool next(int i, Unit& u) const {
        const long L = (long)i * G + c; if (L >= nwg) return false;
        order_map((int)L, nM, nN, u.pm, u.pn); u.pb = u.pn; u.pa = u.pm; return true;
    }
    DI void a_ready(const Unit&) const {}
    DI void done(const Unit&) const {}
};
DI void order_panel(int L, int nM, int nN, int& pm, int& pn) {
    const int nwg = nM * nN;
    int wgid = L; { const int q = nwg / NXCD, r = nwg % NXCD, xcd = wgid % NXCD, off = wgid / NXCD; wgid = (xcd < r ? xcd * (q + 1) : r * (q + 1) + (xcd - r) * q) + off; }
    pm = wgid / nN; pn = wgid - pm * nN;
}
struct MoeOrder {
    int nN, G, c; int tb1, tb2, tb3, tb4, tb5, tb6, tb7, tb8; int sparse_a;
    unsigned* donep;
    DI bool next(int i, Unit& u) const {
        const long L = (long)i * G + c; const int nM = tb8; if (L >= (long)nM * nN) return false;
        if (donep) order_panel((int)L, nM, nN, u.pm, u.pn); else order_map((int)L, nM, nN, u.pm, u.pn);
        const int pm = u.pm;
        const int e = (pm >= tb1) + (pm >= tb2) + (pm >= tb3) + (pm >= tb4) + (pm >= tb5) + (pm >= tb6) + (pm >= tb7);
        const int tbe = e == 0 ? 0 : e == 1 ? tb1 : e == 2 ? tb2 : e == 3 ? tb3 : e == 4 ? tb4 : e == 5 ? tb5 : e == 6 ? tb6 : tb7;
        u.pb = e * nN + u.pn; u.pa = sparse_a ? e * 64 + (pm - tbe) : pm; return true;
    }
    DI void a_ready(const Unit&) const {}
    DI void done(const Unit& u) const {
        if (donep) { asm volatile("s_waitcnt vmcnt(0)" ::: "memory");
            if ((threadIdx.x & 63) == 0) __hip_atomic_fetch_add(donep + 16 * u.pm, 1u, __ATOMIC_RELAXED, __HIP_MEMORY_SCOPE_AGENT); }
    }
};
struct PairOrder {
    int G, c, wofs;
    DI bool next(int i, Unit& u) const {
        const long L = (long)(i >> 1) * G + c; if (L >= 64 * 8) return false;
        order_map((int)L, 64, 8, u.pm, u.pn); const int sub = i & 1; u.pa = u.pm + 64 * sub; u.pb = wofs + u.pn + 16 * sub; return true;
    }
    DI void a_ready(const Unit&) const {}
    DI void done(const Unit&) const {}
};

template <int MM = 0  , class Epi, class Sched, bool ALIGN_EPI = true, bool SP2 = true>
DI void gemm_phase(LAS unsigned char* lds, const Gemm g, const Sched& S, const Epi& E) {
    int tid_ = threadIdx.x; asm volatile("" : "+v"(tid_));
    const int tid = tid_, wid = __builtin_amdgcn_readfirstlane(tid >> 6), lane = tid & 63, wr = wid >> 2, wc = wid & 3, fr = lane & 15, fq = lane >> 4;
    constexpr bool FP8 = (MM == 1), I8 = (MM == 2);
    const int Kb = g.Kb, nt = Kb / (BK * 2);
    unsigned voffA[2], voffB[2];
#pragma unroll
    for (int i = 0; i < 2; ++i) { int R, C; stage_rc(tid * 16 + i * 8192, R, C); const int Rb = Epi::PERM ? ((R & ~31) + perm32(R & 31)) : R;
        voffA[i] = (unsigned)(R * Kb + C * 2); voffB[i] = (unsigned)(Rb * Kb + C * 2); }
    const size_t kstep = (size_t)(BK * 2);
    const size_t hstep = (size_t)HALF * Kb;
    const size_t tstep = 2 * hstep;
    const unsigned ldsw = (unsigned)wid * 1024u;
    const int aoff = lds_byte(wr * 64 + fr, fq * 8), boff = lds_byte(wc * 32 + fr, fq * 8);
#define PG8_SA(b, h) (((b) * 2 + (h)) * HTB)
#define PG8_SB(b, h) ((4 + (b) * 2 + (h)) * HTB)
#define PG8_STAGE(bufoff, gbase, voff) do { _Pragma("unroll") for (int _i = 0; _i < 2; ++_i) \
        __builtin_amdgcn_global_load_lds((const unsigned*)((const char*)(gbase) + (voff)[_i]), (LAS unsigned*)(lds + (bufoff) + ldsw + _i * 8192), 16, 0, 0); } while (0)
#define PG8_LDA(dst, b, h) do { _Pragma("unroll") for (int m = 0; m < 4; ++m) _Pragma("unroll") for (int k = 0; k < 2; ++k) dst[m][k] = *(const LAS bf16x8*)(lds + PG8_SA(b, h) + aoff + m * 2048 + k * 1024); } while (0)
#define PG8_LDB(dst, b, h) do { _Pragma("unroll") for (int n = 0; n < 2; ++n) _Pragma("unroll") for (int k = 0; k < 2; ++k) dst[n][k] = *(const LAS bf16x8*)(lds + PG8_SB(b, h) + boff + n * 2048 + k * 1024); } while (0)
#define PG8_MMA(ai, bj, At, Bt) do { __builtin_amdgcn_s_setprio(3); _Pragma("unroll") for (int m = 0; m < 4; ++m) _Pragma("unroll") for (int n = 0; n < 2; ++n) { \
        if constexpr (FP8) { const i32x8 bb = __builtin_shufflevector(__builtin_bit_cast(i32x4, Bt[n][0]), __builtin_bit_cast(i32x4, Bt[n][1]), 0, 1, 2, 3, 4, 5, 6, 7); \
                             const i32x8 aa = __builtin_shufflevector(__builtin_bit_cast(i32x4, At[m][0]), __builtin_bit_cast(i32x4, At[m][1]), 0, 1, 2, 3, 4, 5, 6, 7); \
                             asm volatile("v_mfma_scale_f32_16x16x128_f8f6f4 %0, %1, %2, %0, %3, %3 op_sel_hi:[0,0,0]" : "+v"(acc[ai][bj][m][n]) : "v"(bb), "v"(aa), "v"(sc8)); } \
        else if constexpr (I8) { _Pragma("unroll") for (int k = 0; k < 2; ++k) acc[ai][bj][m][n] = __builtin_bit_cast(f32x4, __builtin_amdgcn_mfma_i32_16x16x64_i8(__builtin_bit_cast(i32x4, Bt[n][k]), __builtin_bit_cast(i32x4, At[m][k]), __builtin_bit_cast(i32x4, acc[ai][bj][m][n]), 0, 0, 0)); } \
        else { _Pragma("unroll") for (int k = 0; k < 2; ++k) acc[ai][bj][m][n] = __builtin_amdgcn_mfma_f32_16x16x32_bf16(Bt[n][k], At[m][k], acc[ai][bj][m][n], 0, 0, 0); } } \
        __builtin_amdgcn_s_setprio(0); } while (0)
#define PG8_WAIT_V(n) asm volatile("s_waitcnt vmcnt(" #n ")" ::: "memory")
#define PG8_WAIT_L(n) asm volatile("s_waitcnt lgkmcnt(" #n ")" ::: "memory")
#define PG8_BAR __builtin_amdgcn_s_barrier()
#define PG8_SCHED __builtin_amdgcn_sched_barrier(0)
    int sc8 = 0x7f7f7f7f; if constexpr (FP8) asm volatile("" : "+v"(sc8));
    (void)sc8;
    Unit cur, nxt; int ui = 0;
    if (!S.next(0, cur)) return;
    f32x4 acc[2][2][4][2];
#pragma unroll
    for (int a = 0; a < 2; ++a)
#pragma unroll
        for (int b = 0; b < 2; ++b)
#pragma unroll
            for (int m = 0; m < 4; ++m)
#pragma unroll
                for (int n = 0; n < 2; ++n) acc[a][b][m][n] = (f32x4){0.f, 0.f, 0.f, 0.f};
    bf16x8 At[4][2], B0[2][2], B1[2][2];
    const char* cA = (const char*)g.A + (size_t)cur.pa * tstep; const char* cB = (const char*)g.Bt + (size_t)cur.pb * tstep;
    S.a_ready(cur);
    if constexpr (SP2) {
        PG8_STAGE(PG8_SB(0, 0), cB, voffB); PG8_STAGE(PG8_SB(0, 1), cB + hstep, voffB); PG8_STAGE(PG8_SA(0, 0), cA, voffA); PG8_STAGE(PG8_SA(0, 1), cA + hstep, voffA);
        if (wr == 1) PG8_BAR;
        PG8_WAIT_V(2); PG8_BAR;
        PG8_STAGE(PG8_SB(1, 0), cB + kstep, voffB); PG8_STAGE(PG8_SA(1, 0), cA + kstep, voffA); PG8_STAGE(PG8_SB(1, 1), cB + hstep + kstep, voffB);
        PG8_WAIT_V(6); PG8_BAR;
    } else {
        PG8_STAGE(PG8_SB(0, 0), cB, voffB); PG8_STAGE(PG8_SA(0, 0), cA, voffA); PG8_STAGE(PG8_SB(0, 1), cB + hstep, voffB); PG8_STAGE(PG8_SA(0, 1), cA + hstep, voffA);
        if (wr == 1) PG8_BAR;
        PG8_WAIT_V(4); PG8_BAR;
        PG8_STAGE(PG8_SB(1, 0), cB + kstep, voffB); PG8_STAGE(PG8_SA(1, 0), cA + kstep, voffA); PG8_STAGE(PG8_SB(1, 1), cB + hstep + kstep, voffB);
        PG8_WAIT_V(6); PG8_BAR;
    }
    for (;;) {
        const bool has_next = S.next(ui + 1, nxt);
        const char* nA = has_next ? (const char*)g.A + (size_t)nxt.pa * tstep : cA; const char* nB = has_next ? (const char*)g.Bt + (size_t)nxt.pb * tstep : cB;
        for (int t = 0; t < nt; t += 2) {
            const bool last = (t == nt - 2);
            const char* a1 = cA + (size_t)(t + 1) * kstep;
            const char* a2 = last ? nA : cA + (size_t)(t + 2) * kstep; const char* b2 = last ? nB : cB + (size_t)(t + 2) * kstep;
            const char* a3 = a2 + kstep; const char* b3 = b2 + kstep;
            if (last && has_next) S.a_ready(nxt);
            if constexpr (SP2) {
            PG8_LDB(B0, 0, 0); PG8_LDB(B1, 0, 1); PG8_SCHED; PG8_LDA(At, 0, 0); PG8_STAGE(PG8_SA(1, 1), a1 + hstep, voffA);
            PG8_WAIT_V(8); PG8_WAIT_L(0); PG8_BAR; PG8_MMA(0, 0, At, B0); PG8_MMA(0, 1, At, B1); PG8_BAR; PG8_SCHED;
            PG8_LDA(At, 0, 1); PG8_STAGE(PG8_SB(0, 0), b2, voffB); PG8_STAGE(PG8_SB(0, 1), b2 + hstep, voffB); PG8_STAGE(PG8_SA(0, 0), a2, voffA);
            PG8_WAIT_V(8); PG8_WAIT_L(0); PG8_BAR; PG8_MMA(1, 0, At, B0); PG8_MMA(1, 1, At, B1); PG8_BAR; PG8_SCHED;
            PG8_LDB(B0, 1, 0); PG8_LDB(B1, 1, 1); PG8_SCHED; PG8_LDA(At, 1, 0); PG8_STAGE(PG8_SA(0, 1), a2 + hstep, voffA);
            PG8_WAIT_V(8); PG8_WAIT_L(0); PG8_BAR; PG8_MMA(0, 0, At, B0); PG8_MMA(0, 1, At, B1); PG8_BAR; PG8_SCHED;
            PG8_LDA(At, 1, 1); PG8_STAGE(PG8_SB(1, 0), b3, voffB); PG8_STAGE(PG8_SB(1, 1), b3 + hstep, voffB); PG8_STAGE(PG8_SA(1, 0), a3, voffA);
            PG8_WAIT_V(8); PG8_WAIT_L(0); PG8_BAR; PG8_MMA(1, 0, At, B0); PG8_MMA(1, 1, At, B1); PG8_BAR; PG8_SCHED;
            } else {
            PG8_LDB(B0, 0, 0); PG8_SCHED; PG8_LDA(At, 0, 0); PG8_STAGE(PG8_SA(1, 1), a1 + hstep, voffA);
            PG8_WAIT_L(8); PG8_BAR; PG8_WAIT_L(0); PG8_MMA(0, 0, At, B0); PG8_BAR; PG8_SCHED;
            PG8_LDB(B1, 0, 1); PG8_STAGE(PG8_SB(0, 0), b2, voffB);
            PG8_BAR; PG8_WAIT_L(0); PG8_MMA(0, 1, At, B1); PG8_BAR;
            PG8_LDA(At, 0, 1); PG8_STAGE(PG8_SA(0, 0), a2, voffA);
            PG8_BAR; PG8_WAIT_L(0); PG8_MMA(1, 0, At, B0); PG8_BAR; PG8_SCHED;
            PG8_STAGE(PG8_SB(0, 1), b2 + hstep, voffB);
            PG8_WAIT_V(6); PG8_BAR; PG8_MMA(1, 1, At, B1); PG8_BAR;
            PG8_LDB(B0, 1, 0); PG8_SCHED; PG8_LDA(At, 1, 0); PG8_STAGE(PG8_SA(0, 1), a2 + hstep, voffA);
            PG8_WAIT_L(8); PG8_BAR; PG8_WAIT_L(0); PG8_MMA(0, 0, At, B0); PG8_BAR; PG8_SCHED;
            PG8_LDB(B1, 1, 1); PG8_STAGE(PG8_SB(1, 0), b3, voffB);
            PG8_BAR; PG8_WAIT_L(0); PG8_MMA(0, 1, At, B1); PG8_BAR;
            PG8_LDA(At, 1, 1); PG8_STAGE(PG8_SA(1, 0), a3, voffA);
            PG8_BAR; PG8_WAIT_L(0); PG8_MMA(1, 0, At, B0); PG8_BAR; PG8_SCHED;
            PG8_STAGE(PG8_SB(1, 1), b3 + hstep, voffB);
            PG8_WAIT_V(6); PG8_BAR; PG8_MMA(1, 1, At, B1); PG8_BAR;
            }
        }
        if constexpr (FP8) asm volatile("s_nop 15\n\ts_nop 7" ::: "memory");
        if constexpr (ALIGN_EPI) { if (wr == 0) PG8_BAR; }
        if constexpr (I8) {
#pragma unroll
            for (int a = 0; a < 2; ++a)
#pragma unroll
                for (int b = 0; b < 2; ++b)
#pragma unroll
                    for (int m = 0; m < 4; ++m)
#pragma unroll
                        for (int n = 0; n < 2; ++n) acc[a][b][m][n] = __builtin_convertvector(__builtin_bit_cast(i32x4, acc[a][b][m][n]), f32x4);
        }
        E(acc, cur, wr, wc, fr, fq); S.done(cur);
        if (!has_next) break;
        if (!(Epi::PAIR && (ui & 1) == 0)) {
#pragma unroll
        for (int a = 0; a < 2; ++a)
#pragma unroll
            for (int b = 0; b < 2; ++b)
#pragma unroll
                for (int m = 0; m < 4; ++m)
#pragma unroll
                    for (int n = 0; n < 2; ++n) acc[a][b][m][n] = (f32x4){0.f, 0.f, 0.f, 0.f};
        }
        cur = nxt; cA = nA; cB = nB; ++ui;
        if constexpr (ALIGN_EPI) { if (wr == 1) PG8_BAR; }
    }
    PG8_WAIT_V(0);
    if constexpr (!ALIGN_EPI) { if (wr == 0) PG8_BAR; }
    PG8_BAR;
#undef PG8_SA
#undef PG8_SB
#undef PG8_STAGE
#undef PG8_LDA
#undef PG8_LDB
#undef PG8_MMA
#undef PG8_WAIT_V
#undef PG8_WAIT_L
#undef PG8_BAR
#undef PG8_SCHED
}

DI u32x4 pack8(const f32x4 a, const f32x4 b) { u32x4 w; w.x = pk2(a[0], a[1]); w.y = pk2(a[2], a[3]); w.z = pk2(b[0], b[1]); w.w = pk2(b[2], b[3]); return w; }
DI void unpack8(const u32x4 w, f32x4& a, f32x4& b) { a = (f32x4){bf_lo(w.x), bf_hi(w.x), bf_lo(w.y), bf_hi(w.y)}; b = (f32x4){bf_lo(w.z), bf_hi(w.z), bf_lo(w.w), bf_hi(w.w)}; }

struct EpiInProj {
    static constexpr bool PERM = true, PAIR = false;
    bf16_t *Q, *Kk, *V, *SG, *CB, *U, *SGA, *SGB; const float *tabc, *tabs; const ss_t* ss; float sc;
    template <int ACT> DI void plain(const f32x4 (&acc)[2][2][4][2], bf16_t* dst, int row0, int col0) const {
#pragma unroll
        for (int ai = 0; ai < 2; ++ai)
#pragma unroll
            for (int m = 0; m < 4; ++m) { bf16_t* rowp = dst + (size_t)(row0 + ai * 128 + m * 16) * 2048 + col0;
#pragma unroll
                for (int bj = 0; bj < 2; ++bj) { f32x4 v0 = acc[ai][bj][m][0], v1 = acc[ai][bj][m][1];
                    if (ACT == 1) {
#pragma unroll
                        for (int j = 0; j < 4; ++j) { v0[j] = fsilu(v0[j]); v1[j] = fsilu(v1[j]); } }
                    if (ACT == 2) {
#pragma unroll
                        for (int j = 0; j < 4; ++j) { v0[j] = fsigmoid(v0[j]); v1[j] = fsigmoid(v1[j]); } }
                    *(u32x4*)(rowp + bj * 128) = pack8(v0, v1); } }
    }
    DI void operator()(f32x4 (&acc)[2][2][4][2], const Unit& u, int wr, int wc, int fr, int fq) const {
        const int pn = u.pn, row0 = u.pm * 256 + wr * 64 + fr, cl = wc * 32 + 8 * fq;
        {
            float rs[2][4];
#pragma unroll
            for (int ai = 0; ai < 2; ++ai)
#pragma unroll
                for (int m = 0; m < 4; ++m) rs[ai][m] = ss_rstd(ss, row0 + ai * 128 + m * 16) * sc;
#pragma unroll
            for (int ai = 0; ai < 2; ++ai)
#pragma unroll
                for (int m = 0; m < 4; ++m)
#pragma unroll
                    for (int bj = 0; bj < 2; ++bj) { acc[ai][bj][m][0] = acc[ai][bj][m][0] * rs[ai][m]; acc[ai][bj][m][1] = acc[ai][bj][m][1] * rs[ai][m]; }
        }
        if (pn < 8) {
            const bool isq = pn < 4; const int hh = pn & 3; bf16_t* dst = (isq ? Q : Kk) + hh * 256 + cl; const float l2g = log2gamma(hh);
#pragma unroll
            for (int ai = 0; ai < 2; ++ai) {
                f32x4 cs[4][4];
#pragma unroll
                for (int m = 0; m < 4; ++m) { const int row = row0 + ai * 128 + m * 16; const float* cp = tabc + (size_t)row * 128 + cl; const float* sp = tabs + (size_t)row * 128 + cl;
                    cs[m][0] = *(const f32x4*)cp; cs[m][1] = *(const f32x4*)(cp + 4); cs[m][2] = *(const f32x4*)sp; cs[m][3] = *(const f32x4*)(sp + 4); }
#pragma unroll
                for (int m = 0; m < 4; ++m) { const int row = row0 + ai * 128 + m * 16; const float tc1 = (float)(wr * 64 + m * 16 + fr + 1);
                    const float sc = isq ? 0.0625f * __builtin_amdgcn_exp2f(tc1 * l2g) : __builtin_amdgcn_exp2f(-tc1 * l2g);
                    const f32x4 c0 = cs[m][0], c1 = cs[m][1], s0 = cs[m][2], s1 = cs[m][3];
                    const f32x4 x1a = acc[ai][0][m][0], x1b = acc[ai][0][m][1], x2a = acc[ai][1][m][0], x2b = acc[ai][1][m][1];
                    const f32x4 o1a = (x1a * c0 - x2a * s0) * sc, o1b = (x1b * c1 - x2b * s1) * sc, o2a = (x1a * s0 + x2a * c0) * sc, o2b = (x1b * s1 + x2b * c1) * sc;
                    bf16_t* rowp = dst + (size_t)row * 1024;
                    *(u32x4*)rowp = pack8(o1a, o1b); *(u32x4*)(rowp + 128) = pack8(o2a, o2b); }
            }
        } else if (pn >= 32 && pn < 48) {
            bf16_t* dst = U + (pn - 32) * 128 + cl;
#pragma unroll
            for (int ai = 0; ai < 2; ++ai)
#pragma unroll
                for (int m = 0; m < 4; ++m) { const int row = row0 + ai * 128 + m * 16;
                    *(u32x4*)(dst + (size_t)row * 2048) = pack8(acc[ai][0][m][0] * acc[ai][1][m][0], acc[ai][0][m][1] * acc[ai][1][m][1]); }
        } else if (pn < 16) plain<0>(acc, V, row0, (pn - 8) * 256 + cl);
        else if (pn < 24) plain<1>(acc, SG, row0, (pn - 16) * 256 + cl);
        else if (pn < 32) plain<0>(acc, CB, row0, (pn - 24) * 256 + cl);
        else {
            unsigned char* dst = (unsigned char*)(pn < 56 ? SGA : SGB) + ((pn - 48) & 7) * 256 + cl;
#pragma unroll
            for (int ai = 0; ai < 2; ++ai)
#pragma unroll
                for (int m = 0; m < 4; ++m) { unsigned char* rowp = dst + (size_t)(row0 + ai * 128 + m * 16) * 2048;
#pragma unroll
                    for (int bj = 0; bj < 2; ++bj) { const f32x4 v0 = acc[ai][bj][m][0], v1 = acc[ai][bj][m][1]; u32x2 w;
                        w.x = pk4_u8(fsigmoid(v0[0]), fsigmoid(v0[1]), fsigmoid(v0[2]), fsigmoid(v0[3])); w.y = pk4_u8(fsigmoid(v1[0]), fsigmoid(v1[1]), fsigmoid(v1[2]), fsigmoid(v1[3]));
                        *(u32x2*)(rowp + bj * 128) = w; } }
        }
    }
};
struct EpiGatePair {
    static constexpr bool PERM = true, PAIR = true;
    const unsigned char *ga, *gb; unsigned char* out8;
    DI void operator()(f32x4 (&acc)[2][2][4][2], const Unit& u, int wr, int wc, int fr, int fq) const {
        const int row0 = u.pm * 256 + wr * 64 + fr, col0 = u.pn * 256 + wc * 32 + 8 * fq;
        const bool first = u.pa < 64;
#pragma unroll
        for (int ai = 0; ai < 2; ++ai) {
            u32x2 av[4][2], bv[4][2];
#pragma unroll
            for (int m = 0; m < 4; ++m)
#pragma unroll
                for (int bj = 0; bj < 2; ++bj) { const size_t off = (size_t)(row0 + ai * 128 + m * 16) * 2048 + col0 + bj * 128;
                    bv[m][bj] = *(const u32x2*)(gb + off); if (first) av[m][bj] = *(const u32x2*)(ga + off); }
            if (first) {
#pragma unroll
                for (int m = 0; m < 4; ++m)
#pragma unroll
                    for (int bj = 0; bj < 2; ++bj) {
                        const f32x4 a0 = u8x4_f(av[m][bj].x), a1 = u8x4_f(av[m][bj].y), b0 = u8x4_f(bv[m][bj].x), b1 = u8x4_f(bv[m][bj].y);
                        f32x4 r0, r1;
#pragma unroll
                        for (int j = 0; j < 4; ++j) { r0[j] = a0[j] * __builtin_amdgcn_rcpf(b0[j]); r1[j] = a1[j] * __builtin_amdgcn_rcpf(b1[j]); }
                        acc[ai][bj][m][0] = acc[ai][bj][m][0] * r0; acc[ai][bj][m][1] = acc[ai][bj][m][1] * r1; }
            } else {
#pragma unroll
                for (int m = 0; m < 4; ++m)
#pragma unroll
                    for (int bj = 0; bj < 2; ++bj) { const size_t off = (size_t)(row0 + ai * 128 + m * 16) * 2048 + col0 + bj * 128;
                        const f32x4 v0 = acc[ai][bj][m][0] * u8x4_f(bv[m][bj].x) * I8_SG, v1 = acc[ai][bj][m][1] * u8x4_f(bv[m][bj].y) * I8_SG;
                        u32x2 w8; w8.x = pk4_i8(v0[0], v0[1], v0[2], v0[3]); w8.y = pk4_i8(v1[0], v1[1], v1[2], v1[3]); *(u32x2*)(out8 + off) = w8; }
            }
        }
    }
};
template <bool BASE_F32> struct EpiResidB {
    static constexpr bool PERM = true, PAIR = false;
    const void* base; bf16_t* out; ss_t* ss; LAS float* red; unsigned char* out8; float s8, sc;
    DI void operator()(const f32x4 (&acc)[2][2][4][2], const Unit& u, int wr, int wc, int fr, int fq) const {
        const int row0 = u.pm * 256 + wr * 64 + fr, col0 = u.pn * 256 + wc * 32 + 8 * fq;
#pragma unroll
        for (int ai = 0; ai < 2; ++ai) {
            f32x4 b0[4][2], b1[4][2];
#pragma unroll
            for (int m = 0; m < 4; ++m)
#pragma unroll
                for (int bj = 0; bj < 2; ++bj) { const size_t off = (size_t)(row0 + ai * 128 + m * 16) * 2048 + col0 + bj * 128;
                    if (BASE_F32) { b0[m][bj] = *(const f32x4*)((const float*)base + off); b1[m][bj] = *(const f32x4*)((const float*)base + off + 4); }
                    else unpack8(*(const u32x4*)((const bf16_t*)base + off), b0[m][bj], b1[m][bj]); }
#pragma unroll
            for (int m = 0; m < 4; ++m) { float s = 0.f;
#pragma unroll
                for (int bj = 0; bj < 2; ++bj) { const size_t off = (size_t)(row0 + ai * 128 + m * 16) * 2048 + col0 + bj * 128;
                    const f32x4 v0 = b0[m][bj] + acc[ai][bj][m][0] * sc, v1 = b1[m][bj] + acc[ai][bj][m][1] * sc;
                    s += (v0[0] * v0[0] + v0[1] * v0[1]) + (v0[2] * v0[2] + v0[3] * v0[3]) + (v1[0] * v1[0] + v1[1] * v1[1]) + (v1[2] * v1[2] + v1[3] * v1[3]);
                    *(u32x4*)(out + off) = pack8(v0, v1);
                    if (out8) { const f32x4 q0 = v0 * s8, q1 = v1 * s8; u32x2 w8; w8.x = pk4_i8(q0[0], q0[1], q0[2], q0[3]); w8.y = pk4_i8(q1[0], q1[1], q1[2], q1[3]); *(u32x2*)(out8 + off) = w8; } }
                s += __shfl_xor(s, 16); s += __shfl_xor(s, 32);
                if (fq == 0) red[(ai * 128 + wr * 64 + m * 16 + fr) * 4 + wc] = s; }
        }
        asm volatile("s_waitcnt lgkmcnt(0)" ::: "memory"); __builtin_amdgcn_s_barrier(); asm volatile("" ::: "memory");
        { const int t = (wr * 4 + wc) * 64 + fq * 16 + fr; if (t < 256) { const f32x4 p = *(const LAS f32x4*)(red + t * 4); ss[(size_t)(u.pm * 256 + t) * 8 + u.pn] = (p.x + p.y) + (p.z + p.w); } }
    }
};
struct EpiSwiglu {
    static constexpr bool PERM = true, PAIR = false;
    bf16_t* out; const ss_t* ss; float sc;
    DI void operator()(const f32x4 (&acc)[2][2][4][2], const Unit& u, int wr, int wc, int fr, int fq) const {
        const int row0 = u.pm * 256 + wr * 64 + fr; bf16_t* dst = out + u.pn * 128 + wc * 32 + 8 * fq;
        float rsv[2][4];
#pragma unroll
        for (int ai = 0; ai < 2; ++ai)
#pragma unroll
            for (int m = 0; m < 4; ++m) rsv[ai][m] = ss_rstd(ss, row0 + ai * 128 + m * 16) * sc;
#pragma unroll
        for (int ai = 0; ai < 2; ++ai)
#pragma unroll
            for (int m = 0; m < 4; ++m) { const int row = row0 + ai * 128 + m * 16; const float rs = rsv[ai][m];
                f32x4 a0 = acc[ai][0][m][0] * rs, a1 = acc[ai][0][m][1] * rs;
#pragma unroll
                for (int j = 0; j < 4; ++j) { a0[j] = fsilu(a0[j]); a1[j] = fsilu(a1[j]); }
                *(u32x4*)(dst + (size_t)row * D_FF) = pack8(a0 * (acc[ai][1][m][0] * rs), a1 * (acc[ai][1][m][1] * rs)); }
    }
};
struct EpiSwiglu8 {
    static constexpr bool PERM = true, PAIR = false;
    unsigned char* out; float sc;
    DI void operator()(const f32x4 (&acc)[2][2][4][2], const Unit& u, int wr, int wc, int fr, int fq) const {
        const int row0 = u.pm * 256 + wr * 64 + fr; unsigned char* dst = out + u.pn * 128 + wc * 32 + 8 * fq;
#pragma unroll
        for (int ai = 0; ai < 2; ++ai)
#pragma unroll
            for (int m = 0; m < 4; ++m) { f32x4 a0 = acc[ai][0][m][0] * sc, a1 = acc[ai][0][m][1] * sc;
#pragma unroll
                for (int j = 0; j < 4; ++j) { a0[j] = fsilu(a0[j]); a1[j] = fsilu(a1[j]); }
                a0 = a0 * (acc[ai][1][m][0] * sc); a1 = a1 * (acc[ai][1][m][1] * sc);
                u32x2 w; w.x = pk4_fp8(a0[0], a0[1], a0[2], a0[3]); w.y = pk4_fp8(a1[0], a1[1], a1[2], a1[3]);
                *(u32x2*)(dst + (size_t)(row0 + ai * 128 + m * 16) * D_FF) = w; }
    }
};
struct EpiBf16PlainWT {
    static constexpr bool PERM = true, PAIR = false;
    bf16_t* out; float sc;
    DI void operator()(const f32x4 (&acc)[2][2][4][2], const Unit& u, int wr, int wc, int fr, int fq) const {
        const int row0 = u.pm * 256 + wr * 64 + fr, col0 = u.pn * 256 + wc * 32 + 8 * fq;
        const __amdgpu_buffer_rsrc_t rs = __builtin_amdgcn_make_buffer_rsrc((void*)out, 0, MOE_MAX_ROWS * 2048 * 2, 0x00020000);
#pragma unroll
        for (int ai = 0; ai < 2; ++ai)
#pragma unroll
            for (int m = 0; m < 4; ++m) { const unsigned rowb = (unsigned)(((row0 + ai * 128 + m * 16) * 2048 + col0) * 2);
#pragma unroll
                for (int bj = 0; bj < 2; ++bj) __builtin_amdgcn_raw_buffer_store_b128(pack8(acc[ai][bj][m][0] * sc, acc[ai][bj][m][1] * sc), rs, rowb + bj * 256, 0,   16); }
    }
};
}

constexpr size_t MiB = 1u << 20;
constexpr size_t WS_CTL = 0, CTL_ZERO_BYTES = 64 * 1024;
constexpr size_t WS_RT_E = 1 * MiB, WS_RT_POS = WS_RT_E + 128 * 1024, WS_RT_G = WS_RT_POS + 128 * 1024, WS_RT_ROW = WS_RT_G + 128 * 1024;
constexpr size_t WS_TABC = 2 * MiB, WS_TABS = 10 * MiB;
constexpr size_t WS_WIN8 = 18 * MiB, WS_M8 = 82 * MiB, WS_WRET = 146 * MiB, WS_WCONV = 162 * MiB, WS_WOUT = 178 * MiB, WS_W13 = 194 * MiB, WS_W2 = 238 * MiB, WS_MW13 = 260 * MiB, WS_MW2 = 436 * MiB;
constexpr size_t WS_XN = 524 * MiB;
constexpr size_t WS_Q = 588 * MiB, WS_K = 620 * MiB, WS_V = 652 * MiB, WS_SG = 716 * MiB, WS_CB = 780 * MiB, WS_U = 844 * MiB, WS_SGA = 908 * MiB, WS_SGB = 972 * MiB;
constexpr size_t WS_XGS = 780 * MiB;
constexpr size_t WS_ACT = 588 * MiB;
constexpr size_t WS_ORAW = 1036 * MiB, WS_XG = 1100 * MiB, WS_HB = 1236 * MiB, WS_SS = 1300 * MiB, WS_X8 = 1302 * MiB, WS_HB8 = 1334 * MiB, WS_END = 1366 * MiB;
static_assert(WS_MW13 + 8ull * 11264 * 2048 <= WS_MW2 && WS_MW2 + 8ull * 2048 * 5632 <= WS_XN && WS_XGS == WS_CB && WS_XGS + 8ull * 16384 * 2048 <= WS_ORAW && WS_SGB + 64 * MiB <= WS_ORAW && WS_CB == WS_SG + 64 * MiB && WS_WCONV == WS_WRET + 16 * MiB, "d_ws map");
static_assert(WS_ACT + (size_t)M_TOK * D_FF * 2 <= WS_ORAW && WS_ACT + (size_t)MOE_MAX_ROWS * D_FF <= WS_ORAW, "ACT overlay");
constexpr float W8_SCALE = 64.0f;
static_assert(WS_XG + (size_t)MOE_MAX_ROWS * D_MODEL * 2 <= WS_END, "XG");
constexpr int CW_CNT = 1024;
constexpr int CW_BAR = 4096;
constexpr int CW_DONE = 8192;
constexpr unsigned DONE_NEED = 64u;

constexpr int RING_BYTES = 131072, MISC_OFF = RING_BYTES, LDS_BYTES = RING_BYTES + 1024 + 4096;

#define XB_TMO      128
#define XB_XCNT(j)  (256  + 64 * (j))
#define XB_XSUB(j)  (1280 + 64 * (j))
#define XB_XGEN(j)  (2304 + 64 * (j))
#define XB_TOP      3328
#define XB_TOPGEN   3392
#define XCD_BAR_WORDS 3456
#define XB_SPIN_CAP (1u << 18)
DI unsigned xb_ld(unsigned* p)              { return __hip_atomic_load(p, __ATOMIC_RELAXED, __HIP_MEMORY_SCOPE_AGENT); }
DI unsigned xb_add(unsigned* p, unsigned v) { return __hip_atomic_fetch_add(p, v, __ATOMIC_RELAXED, __HIP_MEMORY_SCOPE_AGENT); }
DI unsigned xb_xcc_id() { return (unsigned)__builtin_amdgcn_s_getreg((3 << 11) | 20) & 0xFu; }
#define XB_SPIN(cond, bar) do { unsigned _sp = 0; while (cond) { __builtin_amdgcn_s_sleep(1); \
    if ((++_sp & 255u) == 0u) { if (xb_ld(&(bar)[XB_TMO])) break; if (_sp > XB_SPIN_CAP) { atomicAdd(&(bar)[XB_TMO], 1u); break; } } } } while (0)
struct XcdBarrier { unsigned* bar; unsigned x; volatile LAS unsigned* st; };
DI XcdBarrier xcd_barrier_post(unsigned* bar, volatile LAS unsigned* st) {
    XcdBarrier b; b.bar = bar; b.x = xb_xcc_id(); b.st = st;
    if (threadIdx.x == 0) (void)xb_add(&bar[XB_XCNT(b.x)], 1u);
    return b;
}
DI void xcd_barrier_complete(unsigned* bar, unsigned x, unsigned& nloc, unsigned& nx) {
    const unsigned G = gridDim.x * gridDim.y * gridDim.z;
    unsigned sum, cnt, mine, sp = 0u;
    for (;;) {
        sum = 0u; cnt = 0u; mine = 0u;
#pragma unroll
        for (unsigned j = 0; j < 16; ++j) { const unsigned c = xb_ld(&bar[XB_XCNT(j)]); sum += c; cnt += (c > 0u) ? 1u : 0u; mine = (j == x) ? c : mine; }
        if (sum == G) break;
        __builtin_amdgcn_s_sleep(1);
        if ((++sp & 255u) == 0u) { if (xb_ld(&bar[XB_TMO])) break; if (sp > XB_SPIN_CAP) { atomicAdd(&bar[XB_TMO], 1u); break; } }
    }
    nloc = mine > 0u ? mine : 1u; nx = cnt > 0u ? cnt : 1u;
}
DI void xcd_barrier(const XcdBarrier& b) {
    asm volatile("s_waitcnt vmcnt(0)" ::: "memory");
    __syncthreads();
    if (threadIdx.x == 0) {
        unsigned* bar = b.bar;
        __builtin_amdgcn_s_waitcnt(0);
        unsigned nloc = b.st[0], nx = b.st[1];
        if (nloc == 0u) { xcd_barrier_complete(bar, b.x, nloc, nx); b.st[0] = nloc; b.st[1] = nx; }
        const unsigned old = xb_add(&bar[XB_XSUB(b.x)], 1u);
        const unsigned gen = old / nloc;
        if (old + 1u == (gen + 1u) * nloc) {
            __builtin_amdgcn_fence(__ATOMIC_RELEASE, "agent");
            asm volatile("s_waitcnt vmcnt(0)" ::: "memory");
            const unsigned og = xb_add(&bar[XB_TOP], 1u);
            const unsigned tg = og / nx;
            if (og + 1u == (tg + 1u) * nx) xb_add(&bar[XB_TOPGEN], 1u);
            else XB_SPIN(xb_ld(&bar[XB_TOPGEN]) == tg, bar);
            __builtin_amdgcn_fence(__ATOMIC_ACQUIRE, "agent");
            xb_add(&bar[XB_XGEN(b.x)], 1u);
            asm volatile("s_waitcnt vmcnt(0)" ::: "memory");
        } else {
            XB_SPIN(xb_ld(&bar[XB_XGEN(b.x)]) == gen, bar);
            __builtin_amdgcn_fence(__ATOMIC_ACQUIRE, "agent");
            asm volatile("s_waitcnt vmcnt(0)" ::: "memory");
        }
    }
    __syncthreads();
}

DI void tr_item(const float* W, int K, int N, bf16_t* WT, int drow0, LAS float* scr, int k0, int n0, int lane, const float* gain = nullptr) {
#pragma unroll 8
    for (int i = 0; i < 32; ++i) { const int kk = 2 * i + (lane >> 5); scr[kk * 33 + (lane & 31)] = W[(size_t)(k0 + kk) * N + n0 + (lane & 31)]; }
    const int c = lane & 7;
    f32x4 g0 = {1.f, 1.f, 1.f, 1.f}, g1 = g0;
    if (gain) { g0 = *(const f32x4*)(gain + k0 + 8 * c); g1 = *(const f32x4*)(gain + k0 + 8 * c + 4); }
    LDS_WAIT(); asm volatile("" ::: "memory");
#pragma unroll
    for (int j = 0; j < 4; ++j) { const int n = (lane >> 3) + 8 * j; const LAS float* s = scr + (8 * c) * 33 + n;
        u32x4 o; o.x = pk2(s[0 * 33] * g0.x, s[1 * 33] * g0.y); o.y = pk2(s[2 * 33] * g0.z, s[3 * 33] * g0.w); o.z = pk2(s[4 * 33] * g1.x, s[5 * 33] * g1.y); o.w = pk2(s[6 * 33] * g1.z, s[7 * 33] * g1.w);
        *(u32x4*)(WT + (size_t)(drow0 + n) * K + k0 + 8 * c) = o; }
    LDS_WAIT(); asm volatile("" ::: "memory");
}
template <bool I8 = false> DI void tr_item8(const float* W, int K, int N, unsigned char* WT, int drow0, LAS float* scr, int k0, int n0, int lane, float scale, const float* gain = nullptr) {
#pragma unroll 8
    for (int i = 0; i < 64; ++i) { const int kk = 2 * i + (lane >> 5); scr[kk * 33 + (lane & 31)] = W[(size_t)(k0 + kk) * N + n0 + (lane & 31)] * scale; }
    LDS_WAIT(); asm volatile("" ::: "memory");
    const int c = lane & 7;
    f32x4 g0 = {1.f, 1.f, 1.f, 1.f}, g1 = g0, g2 = g0, g3 = g0;
    if (gain) { const float* gp = gain + k0 + 16 * c; g0 = *(const f32x4*)gp; g1 = *(const f32x4*)(gp + 4); g2 = *(const f32x4*)(gp + 8); g3 = *(const f32x4*)(gp + 12); }
#pragma unroll
    for (int j = 0; j < 4; ++j) { const int n = (lane >> 3) + 8 * j; const LAS float* s = scr + (16 * c) * 33 + n;
        u32x4 o;
        if (I8) { o.x = pk4_i8(s[0 * 33] * g0.x, s[1 * 33] * g0.y, s[2 * 33] * g0.z, s[3 * 33] * g0.w); o.y = pk4_i8(s[4 * 33] * g1.x, s[5 * 33] * g1.y, s[6 * 33] * g1.z, s[7 * 33] * g1.w);
                  o.z = pk4_i8(s[8 * 33] * g2.x, s[9 * 33] * g2.y, s[10 * 33] * g2.z, s[11 * 33] * g2.w); o.w = pk4_i8(s[12 * 33] * g3.x, s[13 * 33] * g3.y, s[14 * 33] * g3.z, s[15 * 33] * g3.w); }
        else { o.x = pk4_fp8(s[0 * 33] * g0.x, s[1 * 33] * g0.y, s[2 * 33] * g0.z, s[3 * 33] * g0.w); o.y = pk4_fp8(s[4 * 33] * g1.x, s[5 * 33] * g1.y, s[6 * 33] * g1.z, s[7 * 33] * g1.w);
               o.z = pk4_fp8(s[8 * 33] * g2.x, s[9 * 33] * g2.y, s[10 * 33] * g2.z, s[11 * 33] * g2.w); o.w = pk4_fp8(s[12 * 33] * g3.x, s[13 * 33] * g3.y, s[14 * 33] * g3.z, s[15 * 33] * g3.w); }
        *(u32x4*)(WT + (size_t)(drow0 + n) * K + k0 + 16 * c) = o; }
    LDS_WAIT(); asm volatile("" ::: "memory");
}
DI int vrow_inproj(int n) {
    if (n < 8192 || n >= 12288) return n;
    if (n < 10240) { const int j = n - 8192; return 8192 + (j >> 7) * 256 + (j & 127); }
    const int j = n - 10240; return 8192 + (j >> 7) * 256 + 128 + (j & 127);
}
DI int vrow_ffn(int n, int second) { return (n >> 7) * 256 + second * 128 + (n & 127); }

struct Args { const void* in[17]; float* out; unsigned char* ws; int ph_lo, ph_hi; };

DI void prologue_phase(const Args& a, LAS unsigned char* lds, int gw, int NGW, int lane, int wave, int tid, int G) {
    unsigned char* ws = a.ws;
    LAS float* scr = (LAS float*)(lds + wave * 16896);
    const float* w_in = (const float*)a.in[5]; const float* w_ret = (const float*)a.in[7]; const float* w_conv = (const float*)a.in[8]; const float* w_out = (const float*)a.in[9];
    const float* f1 = (const float*)a.in[10]; const float* f3 = (const float*)a.in[11]; const float* f2 = (const float*)a.in[12];
    const float* m1 = (const float*)a.in[14]; const float* m3 = (const float*)a.in[15]; const float* m2 = (const float*)a.in[16];
    constexpr int I_G8 = 16 * 512, I_SQ = 32 * 64, I_SQ8 = 16 * 64, I_FF = 5632, I_FF8 = 2816;
    constexpr int NITEMS = 2 * I_G8 + 4 * I_SQ + 2 * I_SQ8 + 2 * I_FF8 + I_FF;
    for (int it = gw; it < NITEMS; it += NGW) {
        int r = it;
        if (r < 2 * I_G8) { const int l = r / I_G8; r -= l * I_G8; const int kb = r / 512, nb = r % 512;
            tr_item8<true>(w_in + (size_t)l * 2048 * 16384, 2048, 16384, ws + WS_WIN8 + (size_t)l * 16384 * 2048, vrow_inproj(32 * nb), scr, 128 * kb, 32 * nb, lane, I8_SW, (const float*)a.in[2] + l * 2048); continue; }
        r -= 2 * I_G8;
        if (r < 4 * I_SQ) { const int which = r / I_SQ; r -= which * I_SQ; const int mat = which >> 1, l = which & 1, kb = r / 64, nb = r % 64;
            const float* src = (mat == 0 ? w_ret : w_conv) + (size_t)l * 2048 * 2048;
            bf16_t* dst = (bf16_t*)(ws + (mat == 0 ? WS_WRET : WS_WCONV)) + (size_t)l * 2048 * 2048;
            tr_item(src, 2048, 2048, dst, 32 * nb, scr, 64 * kb, 32 * nb, lane); continue; }
        r -= 4 * I_SQ;
        if (r < 2 * I_SQ8) { const int l = r / I_SQ8; r -= l * I_SQ8; const int kb = r / 64, nb = r % 64;
            tr_item8<true>(w_out + (size_t)l * 2048 * 2048, 2048, 2048, ws + WS_WOUT + (size_t)l * 2048 * 2048, 32 * nb, scr, 128 * kb, 32 * nb, lane, I8_SW); continue; }
        r -= 2 * I_SQ8;
        if (r < 2 * I_FF8) { const int j = r / I_FF8; r -= j * I_FF8; const int kb = r / 176, nb = r % 176;
            tr_item8<true>(j == 0 ? f1 : f3, 2048, 5632, ws + WS_W13, vrow_ffn(32 * nb, j), scr, 128 * kb, 32 * nb, lane, I8_SW, (const float*)a.in[3]); continue; }
        r -= 2 * I_FF8;
        if (r < I_FF) { const int kb = r / 64, nb = r % 64; tr_item(f2, 5632, 2048, (bf16_t*)(ws + WS_W2), 32 * nb, scr, 64 * kb, 32 * nb, lane); continue; }
        r -= I_FF;
    }
    __syncthreads();
    {
        constexpr int P = 257; LAS float* tile = (LAS float*)lds;
        const int w = tid >> 6, l = tid & 63, c = l & 7;
        f32x4 v[16];
        auto tile_src = [&](int t, int& N) -> const float* { const int e = t / 1056; int r = t - e * 1056; const int j = r / 352; r -= j * 352; const size_t eo = (size_t)e * 2048 * 5632;
            if (j < 2) { const int kb = r / 22, nb = r - kb * 22; N = 5632; return (j == 0 ? m1 : m3) + eo + (size_t)(128 * kb + 16 * w) * 5632 + 256 * nb + 4 * l; }
            const int kb = r / 8, nb = r - kb * 8; N = 2048; return m2 + eo + (size_t)(128 * kb + 16 * w) * 2048 + 256 * nb + 4 * l; };
        int t = (int)blockIdx.x;
        if (t < 8 * 1056) { int N; const float* sp = tile_src(t, N);
#pragma unroll
            for (int i = 0; i < 16; ++i) v[i] = *(const f32x4*)(sp + (size_t)i * N); }
        for (; t < 8 * 1056; t += G) {
            const int e = t / 1056; int r = t - e * 1056; const int j = r / 352; r -= j * 352;
            const float scale = j < 2 ? I8_SW : W8_SCALE;
#pragma unroll
            for (int i = 0; i < 16; ++i) { LAS float* d = tile + (16 * w + i) * P + 4 * l; d[0] = v[i].x * scale; d[1] = v[i].y * scale; d[2] = v[i].z * scale; d[3] = v[i].w * scale; }
            __syncthreads();
            if (t + G < 8 * 1056) { int N; const float* sp = tile_src(t + G, N);
#pragma unroll
                for (int i = 0; i < 16; ++i) v[i] = *(const f32x4*)(sp + (size_t)i * N); }
            unsigned char* WT; int K, k0, n0;
            if (j < 2) { const int kb = r / 22, nb = r - kb * 22; WT = ws + WS_MW13 + (size_t)e * 11264 * 2048; K = 2048; k0 = 128 * kb; n0 = 256 * nb; }
            else { const int kb = r / 8, nb = r - kb * 8; WT = ws + WS_MW2 + (size_t)e * 2048 * 5632; K = 5632; k0 = 128 * kb; n0 = 256 * nb; }
#pragma unroll
            for (int jj = 0; jj < 4; ++jj) { const int n = (tid >> 3) + 64 * jj; const LAS float* s = tile + (16 * c) * P + n;
                u32x4 o;
                if (j < 2) { o.x = pk4_i8(s[0 * P], s[1 * P], s[2 * P], s[3 * P]); o.y = pk4_i8(s[4 * P], s[5 * P], s[6 * P], s[7 * P]); o.z = pk4_i8(s[8 * P], s[9 * P], s[10 * P], s[11 * P]); o.w = pk4_i8(s[12 * P], s[13 * P], s[14 * P], s[15 * P]); }
                else { o.x = pk4_fp8(s[0 * P], s[1 * P], s[2 * P], s[3 * P]); o.y = pk4_fp8(s[4 * P], s[5 * P], s[6 * P], s[7 * P]); o.z = pk4_fp8(s[8 * P], s[9 * P], s[10 * P], s[11 * P]); o.w = pk4_fp8(s[12 * P], s[13 * P], s[14 * P], s[15 * P]); }
                const int drow = j < 2 ? vrow_ffn(n0 + n, j) : n0 + n;
                *(u32x4*)(WT + (size_t)drow * K + k0 + 16 * c) = o; }
            __syncthreads();
        }
    }
    const int* pos = (const int*)a.in[1]; float* tabc = (float*)(ws + WS_TABC); float* tabs = (float*)(ws + WS_TABS);
    for (int idx = (gw * 64 + lane); idx < M_TOK * 128; idx += NGW * 64) { const int m = idx >> 7, i = idx & 127;
        const float inv = exp2f(-(float)i * (13.287712379549449f / 128.0f)); const float ang = (float)pos[m] * inv;
        const double rev = (double)ang * 0.15915494309189535; const float fr = (float)(rev - rint(rev));
        tabc[idx] = __builtin_amdgcn_cosf(fr); tabs[idx] = __builtin_amdgcn_sinf(fr); }
}

DI void cast_rows_phase(const float* x, unsigned char* x8, ss_t* ss, int gw, int NGW, int lane) {
    for (int m = gw; m < M_TOK; m += NGW) {
        const f32x4* xr = (const f32x4*)(x + (size_t)m * 2048) + lane; f32x4 v[8]; float s = 0.f;
#pragma unroll
        for (int j = 0; j < 8; ++j) { v[j] = xr[64 * j]; s += (v[j].x * v[j].x + v[j].y * v[j].y) + (v[j].z * v[j].z + v[j].w * v[j].w); }
        s = wave_sum(s);
        { unsigned* o4 = (unsigned*)(x8 + (size_t)m * 2048) + lane;
#pragma unroll
          for (int j = 0; j < 8; ++j) o4[64 * j] = pk4_i8(v[j].x * I8_SX, v[j].y * I8_SX, v[j].z * I8_SX, v[j].w * I8_SX); }
        if (lane < 8) ss[(size_t)m * 8 + lane] = lane == 0 ? s : 0.0f;
    }
}
template <bool ROUTE>
DI void norm_phase(LAS unsigned char* lds, const bf16_t* hb, const ss_t* ssp, const float* gain, bf16_t* xn, const float* router, unsigned* ctl, unsigned char* ws, int gw, int NGW, int lane, int tid) {
    LAS float* Rl = (LAS float*)lds;
    if (ROUTE) { for (int idx = tid; idx < 2048 * 8; idx += 512) Rl[(idx & 7) * 2048 + (idx >> 3)] = router[idx]; __syncthreads(); }
    f32x4 gv[8];
#pragma unroll
    for (int j = 0; j < 8; ++j) gv[j] = *(const f32x4*)(gain + 4 * lane + 256 * j);
    for (int m = gw; m < M_TOK; m += NGW) {
        const u32x2* xr = (const u32x2*)(hb + (size_t)m * 2048) + lane;
        f32x4 v[8];
#pragma unroll
        for (int j = 0; j < 8; ++j) { const u32x2 w = xr[64 * j]; v[j] = (f32x4){bf_lo(w.x), bf_hi(w.x), bf_lo(w.y), bf_hi(w.y)}; }
        const float rstd = ss_rstd(ssp, m);
        if (!ROUTE) { u32x2* o8 = (u32x2*)(xn + (size_t)m * 2048) + lane;
#pragma unroll
            for (int j = 0; j < 8; ++j) { v[j] = v[j] * rstd * gv[j]; u32x2 w; w.x = pk2(v[j].x, v[j].y); w.y = pk2(v[j].z, v[j].w); o8[64 * j] = w; } }
        if (ROUTE) {
            unsigned q8[8];
#pragma unroll
            for (int j = 0; j < 8; ++j) { v[j] = v[j] * rstd * gv[j]; q8[j] = pk4_i8(v[j].x * I8_SX, v[j].y * I8_SX, v[j].z * I8_SX, v[j].w * I8_SX); }
            int e0 = 0, e1 = 0; float v0 = -3.0e38f, v1 = -3.0e38f;
#pragma unroll 1
            for (int e = 0; e < 8; ++e) { float p = 0.f;
#pragma unroll
                for (int j = 0; j < 8; ++j) { const f32x4 rv = *(const LAS f32x4*)(Rl + e * 2048 + 4 * lane + 256 * j); p += (v[j].x * rv.x + v[j].y * rv.y) + (v[j].z * rv.z + v[j].w * rv.w); }
                const float xl = wave_sum(p);
                if (xl > v0) { v1 = v0; e1 = e0; v0 = xl; e0 = e; } else if (xl > v1) { v1 = xl; e1 = e; } }
            unsigned p0 = 0u, p1 = 0u;
            if (lane == 0) {
                const float ex = __expf(v1 - v0); const float g0 = 1.0f / (1.0f + ex), g1 = ex / (1.0f + ex);
                p0 = __hip_atomic_fetch_add(ctl + CW_CNT + 64 * e0, 1u, __ATOMIC_RELAXED, __HIP_MEMORY_SCOPE_AGENT);
                p1 = __hip_atomic_fetch_add(ctl + CW_CNT + 64 * e1, 1u, __ATOMIC_RELAXED, __HIP_MEMORY_SCOPE_AGENT);
                ((int2*)(ws + WS_RT_E))[m] = make_int2(e0, e1); ((int2*)(ws + WS_RT_POS))[m] = make_int2((int)p0, (int)p1); ((float2*)(ws + WS_RT_G))[m] = make_float2(g0, g1);
            }
            p0 = __builtin_amdgcn_readfirstlane(p0); p1 = __builtin_amdgcn_readfirstlane(p1);
            unsigned* d0 = (unsigned*)(ws + WS_XGS + ((size_t)e0 * 16384 + p0) * 2048) + lane; unsigned* d1 = (unsigned*)(ws + WS_XGS + ((size_t)e1 * 16384 + p1) * 2048) + lane;
#pragma unroll
            for (int j = 0; j < 8; ++j) { d0[64 * j] = q8[j]; d1[64 * j] = q8[j]; }
        }
    }
}

struct MoeBases { int b0, b1, b2, b3, b4, b5, b6, b7, b8; int c0, c1, c2, c3, c4, c5, c6, c7; };
DI MoeBases moe_bases(unsigned* ctl) {
    MoeBases B; int c[8];
#pragma unroll
    for (int e = 0; e < 8; ++e) c[e] = (int)__builtin_amdgcn_readfirstlane(__hip_atomic_load(ctl + CW_CNT + 64 * e, __ATOMIC_RELAXED, __HIP_MEMORY_SCOPE_AGENT));
    B.c0 = c[0]; B.c1 = c[1]; B.c2 = c[2]; B.c3 = c[3]; B.c4 = c[4]; B.c5 = c[5]; B.c6 = c[6]; B.c7 = c[7];
    B.b0 = 0; B.b1 = B.b0 + ((c[0] + 255) & ~255); B.b2 = B.b1 + ((c[1] + 255) & ~255); B.b3 = B.b2 + ((c[2] + 255) & ~255); B.b4 = B.b3 + ((c[3] + 255) & ~255);
    B.b5 = B.b4 + ((c[4] + 255) & ~255); B.b6 = B.b5 + ((c[5] + 255) & ~255); B.b7 = B.b6 + ((c[6] + 255) & ~255); B.b8 = B.b7 + ((c[7] + 255) & ~255);
    return B;
}
DI int moe_base_of(const MoeBases& B, int e) { return e == 0 ? B.b0 : e == 1 ? B.b1 : e == 2 ? B.b2 : e == 3 ? B.b3 : e == 4 ? B.b4 : e == 5 ? B.b5 : e == 6 ? B.b6 : B.b7; }

template <bool MOE, bool LAST>
DI void post_phase(const bf16_t* hb, float* outp, const float* gain, bf16_t* xn, unsigned char* ws, int gw, int NGW, int lane, const unsigned* donep = nullptr) {
    f32x4 gv[8];
#pragma unroll
    for (int j = 0; j < 8; ++j) gv[j] = *(const f32x4*)(gain + 4 * lane + 256 * j);
    const bf16_t* ym = (const bf16_t*)(ws + WS_XG);
    const MoeBases MB = moe_bases((unsigned*)(ws + WS_CTL));
    unsigned todo = 0u; { int idx = 0; for (int m = gw; m < M_TOK; m += NGW, ++idx) todo |= 1u << idx; }
    for (int pass = 0; pass < 2 && todo != 0u; ++pass) {
    unsigned ready = todo;
    if (MOE && donep) {
        ready = 0u; int idx = 0;
        for (int m = gw; m < M_TOK; m += NGW, ++idx) { if (!((todo >> idx) & 1u)) continue;
            const int2 ee = ((const int2*)(ws + WS_RT_E))[m]; const int2 pp = ((const int2*)(ws + WS_RT_POS))[m];
            const unsigned* c0 = donep + 16 * (__builtin_amdgcn_readfirstlane(moe_base_of(MB, ee.x) + pp.x) >> 8); const unsigned* c1 = donep + 16 * (__builtin_amdgcn_readfirstlane(moe_base_of(MB, ee.y) + pp.y) >> 8);
            bool ok = (unsigned)__builtin_amdgcn_readfirstlane(__hip_atomic_load(c0, __ATOMIC_RELAXED, __HIP_MEMORY_SCOPE_AGENT)) >= DONE_NEED && (unsigned)__builtin_amdgcn_readfirstlane(__hip_atomic_load(c1, __ATOMIC_RELAXED, __HIP_MEMORY_SCOPE_AGENT)) >= DONE_NEED;
            if (pass == 1) for (unsigned sp = 0; sp < (1u << 20) && !ok; ++sp) { __builtin_amdgcn_s_sleep(4);
                ok = (unsigned)__builtin_amdgcn_readfirstlane(__hip_atomic_load(c0, __ATOMIC_RELAXED, __HIP_MEMORY_SCOPE_AGENT)) >= DONE_NEED && (unsigned)__builtin_amdgcn_readfirstlane(__hip_atomic_load(c1, __ATOMIC_RELAXED, __HIP_MEMORY_SCOPE_AGENT)) >= DONE_NEED; }
            if (ok || pass == 1) ready |= 1u << idx; }
        if (ready != 0u) { __builtin_amdgcn_fence(__ATOMIC_ACQUIRE, "agent"); asm volatile("s_waitcnt vmcnt(0)" ::: "memory"); }
    }
    todo &= ~ready;
    int idx = 0;
    for (int m = gw; m < M_TOK; m += NGW, ++idx) {
        if (!((ready >> idx) & 1u)) continue;
        int2 r = make_int2(0, 0);
        if (MOE) { const int2 ee = ((const int2*)(ws + WS_RT_E))[m]; const int2 pp = ((const int2*)(ws + WS_RT_POS))[m]; r = make_int2(moe_base_of(MB, ee.x) + pp.x, moe_base_of(MB, ee.y) + pp.y); }
        const u32x2* hr = (const u32x2*)(hb + (size_t)m * 2048) + lane;
        f32x4* xr = (f32x4*)(outp + (size_t)m * 2048) + lane;
        f32x4 v[8]; float s = 0.f;
#pragma unroll
        for (int j = 0; j < 8; ++j) { const u32x2 w = hr[64 * j]; v[j] = (f32x4){bf_lo(w.x), bf_hi(w.x), bf_lo(w.y), bf_hi(w.y)}; }
        if (MOE) { const float2 g = ((const float2*)(ws + WS_RT_G))[m];
            const u32x2* y0 = (const u32x2*)(ym + (size_t)r.x * 2048) + lane; const u32x2* y1 = (const u32x2*)(ym + (size_t)r.y * 2048) + lane;
#pragma unroll
            for (int j = 0; j < 8; ++j) { const u32x2 a = y0[64 * j], b = y1[64 * j];
                v[j].x += g.x * bf_lo(a.x) + g.y * bf_lo(b.x); v[j].y += g.x * bf_hi(a.x) + g.y * bf_hi(b.x); v[j].z += g.x * bf_lo(a.y) + g.y * bf_lo(b.y); v[j].w += g.x * bf_hi(a.y) + g.y * bf_hi(b.y); } }
#pragma unroll
        for (int j = 0; j < 8; ++j) s += (v[j].x * v[j].x + v[j].y * v[j].y) + (v[j].z * v[j].z + v[j].w * v[j].w);
        const float rstd = 1.0f / sqrtf(wave_sum(s) * (1.0f / 2048.0f) + EPS);
        if (LAST) {
#pragma unroll
            for (int j = 0; j < 8; ++j) __builtin_nontemporal_store(v[j] * rstd * gv[j], &xr[64 * j]);
        } else {
            if (MOE) {
#pragma unroll
                for (int j = 0; j < 8; ++j) xr[64 * j] = v[j];
            }
            u32x2* o8 = (u32x2*)(xn + (size_t)m * 2048) + lane;
#pragma unroll
            for (int j = 0; j < 8; ++j) { const f32x4 y = v[j] * rstd * gv[j]; u32x2 w; w.x = pk2(y.x, y.y); w.y = pk2(y.z, y.w); o8[64 * j] = w; }
        }
    }
    }
}

DI void finalize_conv_phase(unsigned char* ws, const float* convw, int gw, int NGW, int lane, int G, int tid) {
    const bf16_t* O = (const bf16_t*)(ws + WS_ORAW); bf16_t* SG = (bf16_t*)(ws + WS_SG);
    for (int m = gw; m < M_TOK; m += NGW) {
#pragma unroll
        for (int hh = 0; hh < 4; ++hh) { const size_t off = (size_t)m * 2048 + hh * 512 + lane * 8;
            f32x4 a, b, ga, gb; pg8::unpack8(*(const u32x4*)(O + off), a, b); pg8::unpack8(*(const u32x4*)(SG + off), ga, gb);
            const float mean = wave_sum((a.x + a.y) + (a.z + a.w) + (b.x + b.y) + (b.z + b.w)) * (1.0f / 512.0f);
            a = a - mean; b = b - mean;
            const float var = wave_sum((a.x * a.x + a.y * a.y) + (a.z * a.z + a.w * a.w) + (b.x * b.x + b.y * b.y) + (b.z * b.z + b.w * b.w)) * (1.0f / 512.0f);
            const float rstd = 1.0f / sqrtf(var + EPS);
            *(u32x4*)(SG + off) = pg8::pack8(a * rstd * ga, b * rstd * gb); }
    }
    const bf16_t* U = (const bf16_t*)(ws + WS_U); bf16_t* CB = (bf16_t*)(ws + WS_CB);
    const int nthr = G * 512, gtid = blockIdx.x * 512 + tid;
    for (int it = gtid; it < (M_TOK / 16) * 256; it += nthr) { const int cg = it & 255, rb = it >> 8, m0 = rb * 16, c0 = cg * 8;
        f32x4 w0a = *(const f32x4*)(convw + c0), w0b = *(const f32x4*)(convw + c0 + 4), w1a = *(const f32x4*)(convw + 2048 + c0), w1b = *(const f32x4*)(convw + 2048 + c0 + 4),
              w2a = *(const f32x4*)(convw + 4096 + c0), w2b = *(const f32x4*)(convw + 4096 + c0 + 4);
        f32x4 p2a = {0.f, 0.f, 0.f, 0.f}, p2b = p2a, p1a = p2a, p1b = p2a;
        if ((m0 & (T_SEQ - 1)) != 0) { pg8::unpack8(*(const u32x4*)(U + (size_t)(m0 - 2) * 2048 + c0), p2a, p2b); pg8::unpack8(*(const u32x4*)(U + (size_t)(m0 - 1) * 2048 + c0), p1a, p1b); }
#pragma unroll 4
        for (int r = 0; r < 16; ++r) { const size_t off = (size_t)(m0 + r) * 2048 + c0; f32x4 ua, ub, ca, cb;
            pg8::unpack8(*(const u32x4*)(U + off), ua, ub); pg8::unpack8(*(const u32x4*)(CB + off), ca, cb);
            const f32x4 ya = w0a * p2a + w1a * p1a + w2a * ua, yb = w0b * p2b + w1b * p1b + w2b * ub;
            *(u32x4*)(CB + off) = pg8::pack8(ca * ya, cb * yb);
            p2a = p1a; p2b = p1b; p1a = ua; p1b = ub; }
    }
}

DI bf16x8 tr_frag(const LAS unsigned char* p0, const LAS unsigned char* p1) {
    const s16x4 lo = __builtin_amdgcn_ds_read_tr16_b64_v4i16((LAS s16x4*)p0), hi = __builtin_amdgcn_ds_read_tr16_b64_v4i16((LAS s16x4*)p1);
    return __builtin_shufflevector(lo, hi, 0, 1, 2, 3, 4, 5, 6, 7);
}
DI void retention_phase(LAS unsigned char* lds, unsigned char* ws, int G) {
    int tid_ = threadIdx.x; asm volatile("" : "+v"(tid_));
    const int tid = tid_, lane = tid & 63, w = __builtin_amdgcn_readfirstlane(tid >> 6), l15 = lane & 15, g = lane >> 4, q = l15 >> 2, p = l15 & 3;
    constexpr int PK = 528, PV = 144, PS = 528;
    LAS unsigned char* KS = lds; LAS unsigned char* VS = lds + 128 * PK; LAS unsigned char* STT = VS + 128 * PV;
    const bf16_t* Qg = (const bf16_t*)(ws + WS_Q); const bf16_t* Kg = (const bf16_t*)(ws + WS_K); const bf16_t* Vg = (const bf16_t*)(ws + WS_V); bf16_t* Og = (bf16_t*)(ws + WS_ORAW);
    for (int unit = blockIdx.x; unit < 256; unit += G) {
        const int b = unit >> 5, hh = (unit >> 3) & 3, sl = unit & 7;
        const float g128 = __builtin_amdgcn_exp2f(128.0f * log2gamma(hh));
        const size_t r0 = (size_t)b * T_SEQ;
        const bf16_t* Qb = Qg + r0 * 1024 + hh * 256; const bf16_t* Kb = Kg + r0 * 1024 + hh * 256; const bf16_t* Vb = Vg + r0 * 2048 + hh * 512 + sl * 64; bf16_t* Ob = Og + r0 * 2048 + hh * 512 + sl * 64;
        f32x4 stt[4][2];
#pragma unroll
        for (int mt = 0; mt < 4; ++mt) { stt[mt][0] = (f32x4){0.f, 0.f, 0.f, 0.f}; stt[mt][1] = (f32x4){0.f, 0.f, 0.f, 0.f}; }
        u32x4 kpre[8], vpre[2];
#pragma unroll
        for (int it = 0; it < 8; ++it) { const int idx = it * 512 + tid; kpre[it] = *(const u32x4*)(Kb + (size_t)(idx >> 5) * 1024 + (idx & 31) * 8); }
#pragma unroll
        for (int it = 0; it < 2; ++it) { const int idx = it * 512 + tid; vpre[it] = *(const u32x4*)(Vb + (size_t)(idx >> 3) * 2048 + (idx & 7) * 8); }
        for (int c = 0; c < 16; ++c) {
#pragma unroll
            for (int it = 0; it < 8; ++it) { const int idx = it * 512 + tid; *(LAS u32x4*)(KS + (idx >> 5) * PK + (idx & 31) * 16) = kpre[it]; }
#pragma unroll
            for (int it = 0; it < 2; ++it) { const int idx = it * 512 + tid; *(LAS u32x4*)(VS + (idx >> 3) * PV + (idx & 7) * 16) = vpre[it]; }
#pragma unroll
            for (int mt = 0; mt < 4; ++mt)
#pragma unroll
                for (int nt = 0; nt < 2; ++nt)
#pragma unroll
                    for (int r = 0; r < 4; ++r) *(LAS bf16_t*)(STT + (16 * mt + 4 * g + r) * PS + (32 * w + 16 * nt + l15) * 2) = f2bf(stt[mt][nt][r]);
            bf16x8 qf[8];
            { const bf16_t* qp = Qb + (size_t)(128 * c + 16 * w + l15) * 1024 + 8 * g;
#pragma unroll
              for (int s = 0; s < 8; ++s) qf[s] = *(const bf16x8*)(qp + 32 * s); }
            __syncthreads();
            if (c + 1 < 16) {
#pragma unroll
                for (int it = 0; it < 8; ++it) { const int idx = it * 512 + tid; kpre[it] = *(const u32x4*)(Kb + (size_t)(128 * (c + 1) + (idx >> 5)) * 1024 + (idx & 31) * 8); }
#pragma unroll
                for (int it = 0; it < 2; ++it) { const int idx = it * 512 + tid; vpre[it] = *(const u32x4*)(Vb + (size_t)(128 * (c + 1) + (idx >> 3)) * 2048 + (idx & 7) * 8); }
            }
            f32x4 oacc[4];
#pragma unroll
            for (int nt = 0; nt < 4; ++nt) oacc[nt] = (f32x4){0.f, 0.f, 0.f, 0.f};
            const int npairs = (w >> 1) + 1, iq = 16 * w + l15;
            for (int pp = 0; pp < npairs; ++pp) {
                const int ja = 2 * pp, jb = ja + 1;
                f32x4 sa = {0.f, 0.f, 0.f, 0.f}, sb = {0.f, 0.f, 0.f, 0.f};
                const LAS unsigned char* ka = KS + (16 * ja + l15) * PK + 16 * g; const LAS unsigned char* kb = ka + 16 * PK;
#pragma unroll
                for (int s = 0; s < 8; ++s) { const bf16x8 fa = *(const LAS bf16x8*)(ka + 64 * s), fb = *(const LAS bf16x8*)(kb + 64 * s);
                    sa = __builtin_amdgcn_mfma_f32_16x16x32_bf16(fa, qf[s], sa, 0, 0, 0); sb = __builtin_amdgcn_mfma_f32_16x16x32_bf16(fb, qf[s], sb, 0, 0, 0); }
#pragma unroll
                for (int e = 0; e < 4; ++e) { sa[e] = (16 * ja + 4 * g + e <= iq) ? sa[e] : 0.f; sb[e] = (16 * jb + 4 * g + e <= iq) ? sb[e] : 0.f; }
                u32x4 pw; pw.x = pk2(sa[0], sa[1]); pw.y = pk2(sa[2], sa[3]); pw.z = pk2(sb[0], sb[1]); pw.w = pk2(sb[2], sb[3]);
                const bf16x8 pf = __builtin_bit_cast(bf16x8, pw);
                const LAS unsigned char* va = VS + (16 * ja + 4 * g + q) * PV + 8 * p; const LAS unsigned char* vb = va + 16 * PV;
#pragma unroll
                for (int nt = 0; nt < 4; ++nt) { const bf16x8 vf = tr_frag(va + 32 * nt, vb + 32 * nt); oacc[nt] = __builtin_amdgcn_mfma_f32_16x16x32_bf16(vf, pf, oacc[nt], 0, 0, 0); }
            }
            { const LAS unsigned char* sp = STT + l15 * PS + 16 * g;
#pragma unroll
              for (int s = 0; s < 8; ++s)
#pragma unroll
                  for (int nt = 0; nt < 4; ++nt) { const bf16x8 sf = *(const LAS bf16x8*)(sp + 16 * nt * PS + 64 * s); oacc[nt] = __builtin_amdgcn_mfma_f32_16x16x32_bf16(sf, qf[s], oacc[nt], 0, 0, 0); } }
            { bf16_t* op = Ob + (size_t)(128 * c + 16 * w + l15) * 2048 + 4 * g;
#pragma unroll
              for (int nt = 0; nt < 4; ++nt) { u32x2 o2; o2.x = pk2(oacc[nt][0], oacc[nt][1]); o2.y = pk2(oacc[nt][2], oacc[nt][3]); *(u32x2*)(op + 16 * nt) = o2; } }
#pragma unroll
            for (int s = 0; s < 4; ++s) {
                const LAS unsigned char* vp = VS + (32 * s + 8 * g + q) * PV + 8 * p; const LAS unsigned char* kp = KS + (32 * s + 8 * g + q) * PK + (32 * w) * 2 + 8 * p;
                bf16x8 af[4], bfv[2];
#pragma unroll
                for (int mt = 0; mt < 4; ++mt) af[mt] = tr_frag(vp + 32 * mt, vp + 4 * PV + 32 * mt);
#pragma unroll
                for (int nt = 0; nt < 2; ++nt) bfv[nt] = tr_frag(kp + 32 * nt, kp + 4 * PK + 32 * nt);
#pragma unroll
                for (int mt = 0; mt < 4; ++mt)
#pragma unroll
                    for (int nt = 0; nt < 2; ++nt) stt[mt][nt] = __builtin_amdgcn_mfma_f32_16x16x32_bf16(af[mt], bfv[nt], stt[mt][nt], 0, 0, 0);
            }
#pragma unroll
            for (int mt = 0; mt < 4; ++mt) { stt[mt][0] = stt[mt][0] * g128; stt[mt][1] = stt[mt][1] * g128; }
            __syncthreads();
        }
    }
}

constexpr int NPHASE = 21;

struct Ctx { unsigned char* ws; unsigned* ctl; float* out; int lo, hi; };
#define IN(k) (C.lo <= (k) && (k) < C.hi)
#define SEAM(k) do { if (IN(k) && IN((k) + 1)) xcd_barrier(bar); } while (0)
#define PHASE_COORDS() int tid = threadIdx.x; asm volatile("" : "+v"(tid)); const int lane = tid & 63, wave = __builtin_amdgcn_readfirstlane(tid >> 6); \
    const int G = gridDim.x; const int vcu = (G % 8 == 0) ? ((int)blockIdx.x % 8) * (G / 8) + (int)blockIdx.x / 8 : (int)blockIdx.x; const int gw = vcu * 8 + wave, NGW = G * 8; (void)lane; (void)gw; (void)NGW

template <int L>
DI void layer_phases(const Args& a, const Ctx& C, LAS unsigned char* lds, const XcdBarrier& bar) {
    constexpr int pb = 1 + 10 * L;
    unsigned char* ws = C.ws;
    ss_t* ssb = (ss_t*)(ws + WS_SS);
    LAS float* red = (LAS float*)(lds + MISC_OFF + 1024);
    bf16_t* HB = (bf16_t*)(ws + WS_HB);
    if (IN(pb + 0)) {
        const int G = gridDim.x;
        pg8::Gemm g{L == 0 ? (const void*)(ws + WS_X8) : (const void*)(ws + WS_HB8), ws + WS_WIN8 + (size_t)L * 16384 * 2048, 2048}; pg8::StaticOrder S; S.init(64, 64, G, (int)blockIdx.x);
        pg8::EpiInProj E{(bf16_t*)(ws + WS_Q), (bf16_t*)(ws + WS_K), (bf16_t*)(ws + WS_V), (bf16_t*)(ws + WS_SG), (bf16_t*)(ws + WS_CB), (bf16_t*)(ws + WS_U), (bf16_t*)(ws + WS_SGA), (bf16_t*)(ws + WS_SGB),
                         (const float*)(ws + WS_TABC), (const float*)(ws + WS_TABS), ssb + (size_t)(L == 0 ? 0 : 2) * M_TOK * 8, 1.0f / ((L == 0 ? I8_SX : I8_SH) * I8_SW)};
        pg8::gemm_phase<2>(lds, g, S, E);
    }
    SEAM(pb + 0);
    if (IN(pb + 1)) retention_phase(lds, ws, (int)gridDim.x);
    SEAM(pb + 1);
    if (IN(pb + 2)) { PHASE_COORDS(); finalize_conv_phase(ws, (const float*)a.in[6] + (size_t)L * 3 * 2048, gw, NGW, lane, G, tid); }
    SEAM(pb + 2);
    if (IN(pb + 3)) {
        const int G = gridDim.x; pg8::PairOrder S{G, (int)blockIdx.x, 8 * L};
        pg8::Gemm g{(const bf16_t*)(ws + WS_SG), (const bf16_t*)(ws + WS_WRET), 4096}; pg8::EpiGatePair E{ws + WS_SGA, ws + WS_SGB, ws + WS_M8}; pg8::gemm_phase(lds, g, S, E);
    }
    SEAM(pb + 3);
    if (IN(pb + 4)) {
        const int G = gridDim.x;
        pg8::Gemm g{ws + WS_M8, ws + WS_WOUT + (size_t)L * 2048 * 2048, 2048}; pg8::StaticOrder S; S.init(64, 8, G, (int)blockIdx.x); constexpr float osc = 1.0f / (I8_SG * I8_SW);
        if (L == 0) { pg8::EpiResidB<true> E{a.in[0], HB, ssb + (size_t)1 * M_TOK * 8, red, ws + WS_X8, I8_SM, osc};     pg8::gemm_phase<2>(lds, g, S, E); }
        else { pg8::EpiResidB<false> E{HB, HB, ssb + (size_t)3 * M_TOK * 8, red, nullptr, 0.f, osc}; pg8::gemm_phase<2>(lds, g, S, E); }
    }
    SEAM(pb + 4);
    if (L == 1) {
        if (IN(pb + 5)) { PHASE_COORDS(); norm_phase<true>(lds, HB, ssb + (size_t)3 * M_TOK * 8, (const float*)a.in[3] + 2048, (bf16_t*)(ws + WS_XN), (const float*)a.in[13], C.ctl, ws, gw, NGW, lane, tid); }
        SEAM(pb + 5);
    }
    if (IN(pb + 7)) {
        const int G = gridDim.x;
        if (L == 0) { pg8::Gemm g{ws + WS_X8, ws + WS_W13, 2048}; pg8::StaticOrder S; S.init(64, 44, G, (int)blockIdx.x); pg8::EpiSwiglu E{(bf16_t*)(ws + WS_ACT), ssb + (size_t)1 * M_TOK * 8, 1.0f / (I8_SM * I8_SW)}; pg8::gemm_phase<2>(lds, g, S, E); }
        else { const MoeBases B = moe_bases(C.ctl); pg8::MoeOrder S{44, G, (int)blockIdx.x, B.b1 >> 8, B.b2 >> 8, B.b3 >> 8, B.b4 >> 8, B.b5 >> 8, B.b6 >> 8, B.b7 >> 8, B.b8 >> 8, 1, nullptr};
               pg8::Gemm g{ws + WS_XGS, ws + WS_MW13, 2048}; pg8::EpiSwiglu8 E{ws + WS_ACT, 1.0f / (I8_SX * I8_SW)}; pg8::gemm_phase<2>(lds, g, S, E); }
    }
    SEAM(pb + 7);
    if (IN(pb + 8)) {
        const int G = gridDim.x;
        if (L == 0) { pg8::Gemm g{(const bf16_t*)(ws + WS_ACT), (const bf16_t*)(ws + WS_W2), 11264}; pg8::StaticOrder S; S.init(64, 8, G, (int)blockIdx.x); pg8::EpiResidB<false> E{HB, HB, ssb + (size_t)2 * M_TOK * 8, red, ws + WS_HB8, I8_SH, 1.0f}; pg8::gemm_phase(lds, g, S, E); }
        else { const MoeBases B = moe_bases(C.ctl); pg8::MoeOrder S{8, G, (int)blockIdx.x, B.b1 >> 8, B.b2 >> 8, B.b3 >> 8, B.b4 >> 8, B.b5 >> 8, B.b6 >> 8, B.b7 >> 8, B.b8 >> 8, 0, C.ctl + CW_DONE};
               pg8::Gemm g{ws + WS_ACT, ws + WS_MW2, 5632}; pg8::EpiBf16PlainWT E{(bf16_t*)(ws + WS_XG), 1.0f / W8_SCALE}; pg8::gemm_phase<1>(lds, g, S, E); }
    }
    if (L == 0) SEAM(pb + 8);
    if (L == 1) { if (IN(pb + 9)) { PHASE_COORDS(); post_phase<true, true>(HB, C.out, (const float*)a.in[4], nullptr, ws, gw, NGW, lane, C.ctl + CW_DONE); } }
}

__global__ void __launch_bounds__(512, 2) mk_fwd(Args a) {
    extern __shared__ __attribute__((aligned(16))) unsigned char lds_raw[];
    LAS unsigned char* lds = (LAS unsigned char*)lds_raw;
    Ctx C; C.ws = a.ws; C.ctl = (unsigned*)(a.ws + WS_CTL); C.out = a.out; C.lo = a.ph_lo; C.hi = a.ph_hi;
    volatile LAS unsigned* MISC = (volatile LAS unsigned*)(lds + MISC_OFF);
    for (int u = threadIdx.x; u < (LDS_BYTES - MISC_OFF) / 4; u += 512) MISC[u] = 0u;
    __syncthreads();
    XcdBarrier bar; bar.bar = C.ctl + CW_BAR; bar.x = 0; bar.st = nullptr;
    if (C.hi - C.lo > 1) bar = xcd_barrier_post(C.ctl + CW_BAR, MISC + 8);
    if (IN(0)) { PHASE_COORDS(); prologue_phase(a, lds, gw, NGW, lane, wave, tid, G);
        __syncthreads(); for (int u = tid; u < (LDS_BYTES - MISC_OFF) / 4; u += 512) MISC[u] = 0u; __syncthreads();
        cast_rows_phase((const float*)a.in[0], C.ws + WS_X8, (ss_t*)(C.ws + WS_SS), gw, NGW, lane); }
    SEAM(0);
    layer_phases<0>(a, C, lds, bar);
    layer_phases<1>(a, C, lds, bar);
}
#undef IN
#undef SEAM

extern "C" void kernel_launch(void* const* d_in, const int* in_sizes, int n_in, void* d_out, int out_size, void* d_ws, size_t ws_size, hipStream_t stream) {
    static int grid = 0;
    if (grid == 0) {
        if (n_in != 17 || out_size != M_TOK * D_MODEL || ws_size < WS_END) { fprintf(stderr, "kernel_launch: unexpected problem (n_in %d, out %d, ws %zu)\n", n_in, out_size, ws_size); grid = -1; return; }
        int dev = 0, cus = 0, per_cu = 0;
        if (hipGetDevice(&dev) != hipSuccess || hipDeviceGetAttribute(&cus, hipDeviceAttributeMultiprocessorCount, dev) != hipSuccess) { grid = -1; return; }
        if (hipFuncSetAttribute((const void*)mk_fwd, hipFuncAttributeMaxDynamicSharedMemorySize, LDS_BYTES) != hipSuccess) { fprintf(stderr, "kernel_launch: hipFuncSetAttribute failed\n"); grid = -1; return; }
        if (hipOccupancyMaxActiveBlocksPerMultiprocessor(&per_cu, (const void*)mk_fwd, 512, LDS_BYTES) != hipSuccess || per_cu < 1) { fprintf(stderr, "kernel_launch: occupancy query says %d\n", per_cu); (void)hipGetLastError(); grid = -1; return; }
        grid = cus;
    }
    if (grid < 0) return;
    (void)hipMemsetAsync((char*)d_ws + WS_CTL, 0, CTL_ZERO_BYTES, stream);
    Args a{};
    for (int i = 0; i < 17; ++i) a.in[i] = d_in[i];
    a.out = (float*)d_out; a.ws = (unsigned char*)d_ws;
#if MK_ONE_LAUNCH
    a.ph_lo = 0; a.ph_hi = NPHASE;
    hipLaunchKernelGGL(mk_fwd, dim3(grid), dim3(512), LDS_BYTES, stream, a);
#else
    for (int k = 0; k < NPHASE; ++k) { if (k == 1 + 6) continue;
        a.ph_lo = k; a.ph_hi = k + 1; hipLaunchKernelGGL(mk_fwd, dim3(grid), dim3(512), LDS_BYTES, stream, a); }
#endif
}
```
